# Optimizing an MI355X kernel written in HIP

```python
import math
import jax, jax.numpy as jnp
from jax import lax
import numpy as np

D_MODEL = 2048
BATCH = 8
SEQ = 2048
DEPTH = 1

NSA_HEADS = 8
NSA_KV_HEADS = 2
NSA_GROUP = NSA_HEADS // NSA_KV_HEADS
HEAD_DIM = 128
NSA_DIM = NSA_HEADS * HEAD_DIM
NSA_KV_DIM = NSA_KV_HEADS * HEAD_DIM
CMP_BLOCK = 32
CMP_STRIDE = 16
SEL_BLOCK = 64
SEL_TOPK = 16
WINDOW = 512
WIN_Q_BLOCK = 128
SEL_Q_BLOCK = 64
ROPE_THETA = 10000.0
FORCE_SCORE = 1e9
DN_HEADS = 8
DN_HEAD_DIM = 128
DN_DIM = DN_HEADS * DN_HEAD_DIM
DN_CHUNK = 64
CONV_K = 4
D_FF = -(-(8 * D_MODEL) // (3 * 256)) * 256
NORM_EPS = 1e-6
NEG_INF = -1e30
IN_SPLITS = (NSA_DIM, 6 * NSA_KV_DIM, 3 * NSA_HEADS, 3 * DN_DIM, DN_DIM, DN_HEADS, DN_HEADS, 2 * D_MODEL)
N_IN = sum(IN_SPLITS)

kernel_name = 'hybrid_nsa_gdn_block'


def rms_norm(x, w):
    xf = x.astype(jnp.float32)
    y = xf * lax.rsqrt(jnp.mean(xf * xf, axis=-1, keepdims=True) + NORM_EPS)
    return (y * w.astype(jnp.float32)).astype(x.dtype)


def l2norm(x):
    return x * lax.rsqrt(jnp.sum(x * x, axis=-1, keepdims=True) + NORM_EPS)


def rope_tables(seq):
    inv = 1.0 / (ROPE_THETA ** (jnp.arange(0, HEAD_DIM, 2, dtype=jnp.float32) / HEAD_DIM))
    ang = jnp.arange(seq, dtype=jnp.float32)[:, None] * inv[None, :]
    return jnp.cos(ang), jnp.sin(ang)


def apply_rope(x, cos, sin):
    x1, x2 = jnp.split(x.astype(jnp.float32), 2, axis=-1)
    c = cos[None, :, None, :]
    s = sin[None, :, None, :]
    return jnp.concatenate([x1 * c - x2 * s, x2 * c + x1 * s], axis=-1).astype(x.dtype)


def masked_softmax(s, mask):
    return jax.nn.softmax(jnp.where(mask, s.astype(jnp.float32), NEG_INF), axis=-1)


def split_points():
    return [int(v) for v in np.cumsum(IN_SPLITS)[:-1]]


def cmp_to_sel_overlap(n_cmp, n_sel):
    cs = np.arange(n_cmp)[:, None] * CMP_STRIDE
    ss = np.arange(n_sel)[None, :] * SEL_BLOCK
    ov = np.clip(np.minimum(cs + CMP_BLOCK, ss + SEL_BLOCK) - np.maximum(cs, ss), 0, None)
    return jnp.asarray(ov / CMP_BLOCK, dtype=jnp.float32)


def compress_blocks(t, pe, w1, w2):
    b, s, hk, d = t.shape
    n_cmp = (s - CMP_BLOCK) // CMP_STRIDE + 1
    idx = np.arange(n_cmp)[:, None] * CMP_STRIDE + np.arange(CMP_BLOCK)[None, :]
    blk = jnp.swapaxes(t[:, idx], 2, 3) + pe
    blk = blk.reshape(b, n_cmp, hk, CMP_BLOCK * d)
    return jax.nn.gelu(blk @ w1) @ w2


def nsa_mixer(q, kv, gate_logits, cmp_pe_k, cmp_w1_k, cmp_w2_k, cmp_pe_v, cmp_w1_v, cmp_w2_v, cos, sin):
    b, s, _, d = q.shape
    hk, g = NSA_KV_HEADS, NSA_GROUP
    scale = HEAD_DIM ** -0.5
    kv = kv.reshape(b, s, 6, hk, d)
    k_c = apply_rope(kv[:, :, 0], cos, sin)
    v_c = kv[:, :, 1]
    k_s = apply_rope(kv[:, :, 2], cos, sin)
    v_s = kv[:, :, 3]
    k_w = apply_rope(kv[:, :, 4], cos, sin)
    v_w = kv[:, :, 5]
    qg = q.reshape(b, s, hk, g, d)
    t_pos = jnp.arange(s)

    kc = compress_blocks(k_c, cmp_pe_k, cmp_w1_k, cmp_w2_k)
    vc = compress_blocks(v_c, cmp_pe_v, cmp_w1_v, cmp_w2_v)
    n_cmp = kc.shape[1]
    s_cmp = jnp.einsum('bshgd,bchd->bhgsc', qg, kc) * scale
    cmp_end = jnp.arange(n_cmp) * CMP_STRIDE + CMP_BLOCK - 1
    cmp_valid = cmp_end[None, :] <= t_pos[:, None]
    p_cmp = masked_softmax(s_cmp, cmp_valid) * jnp.any(cmp_valid, axis=-1)[:, None].astype(jnp.float32)
    o_cmp = jnp.einsum('bhgsc,bchd->bshgd', p_cmp, vc.astype(jnp.float32))

    n_sel = s // SEL_BLOCK
    imp = jnp.einsum('bhgsc,cj->bhsj', p_cmp, cmp_to_sel_overlap(n_cmp, n_sel))
    blk_t = (t_pos // SEL_BLOCK)[:, None]
    j = jnp.arange(n_sel)[None, :]
    forced = (j == 0) | (j == blk_t) | (j == blk_t - 1)
    imp = jnp.where(forced, FORCE_SCORE, jnp.where(j > blk_t, -FORCE_SCORE, imp))
    n_top = min(SEL_TOPK, n_sel)
    _, sel_idx = lax.top_k(imp, n_top)
    kb = k_s.reshape(b, n_sel, SEL_BLOCK, hk, d).transpose(0, 3, 1, 2, 4)
    vb = v_s.reshape(b, n_sel, SEL_BLOCK, hk, d).transpose(0, 3, 1, 2, 4)
    nqb = s // SEL_Q_BLOCK
    q_blocks = qg.reshape(b, nqb, SEL_Q_BLOCK, hk, g, d).transpose(1, 0, 2, 3, 4, 5)
    idx_blocks = sel_idx.reshape(b, hk, nqb, SEL_Q_BLOCK, n_top).transpose(2, 0, 1, 3, 4)
    pos_blocks = t_pos.reshape(nqb, SEL_Q_BLOCK)
    gather = jax.vmap(jax.vmap(lambda blocks, ix: blocks[ix]))

    def sel_block(args):
        qb, ib, tb = args
        kg = gather(kb, ib)
        vg = gather(vb, ib)
        sc = jnp.einsum('bqhgd,bhqnkd->bhgqnk', qb, kg) * scale
        kpos = ib[..., None] * SEL_BLOCK + jnp.arange(SEL_BLOCK)
        valid = (kpos <= tb[None, None, :, None, None]).reshape(b, hk, 1, SEL_Q_BLOCK, n_top * SEL_BLOCK)
        p = masked_softmax(sc.reshape(b, hk, g, SEL_Q_BLOCK, n_top * SEL_BLOCK), valid)
        p = p.reshape(b, hk, g, SEL_Q_BLOCK, n_top, SEL_BLOCK)
        return jnp.einsum('bhgqnk,bhqnkd->bqhgd', p, vg.astype(jnp.float32))

    o_sel = lax.map(sel_block, (q_blocks, idx_blocks, pos_blocks))
    o_sel = o_sel.transpose(1, 0, 2, 3, 4, 5).reshape(b, s, hk, g, d)

    nb = s // WIN_Q_BLOCK
    n_prev = WINDOW // WIN_Q_BLOCK
    pad = ((0, 0), (WINDOW, 0), (0, 0), (0, 0))
    kp = jnp.pad(k_w, pad).reshape(b, nb + n_prev, WIN_Q_BLOCK, hk, d)
    vp = jnp.pad(v_w, pad).reshape(b, nb + n_prev, WIN_Q_BLOCK, hk, d)
    k_band = jnp.concatenate([kp[:, i:i + nb] for i in range(n_prev + 1)], axis=2)
    v_band = jnp.concatenate([vp[:, i:i + nb] for i in range(n_prev + 1)], axis=2)
    qw = qg.reshape(b, nb, WIN_Q_BLOCK, hk, g, d)
    s_win = jnp.einsum('bnqhgd,bnkhd->bhgnqk', qw, k_band) * scale
    qpos = t_pos.reshape(nb, WIN_Q_BLOCK)
    kpos = (jnp.arange(nb) * WIN_Q_BLOCK - WINDOW)[:, None] + jnp.arange((n_prev + 1) * WIN_Q_BLOCK)[None, :]
    diff = qpos[:, :, None] - kpos[:, None, :]
    win_valid = (diff >= 0) & (diff < WINDOW) & (kpos[:, None, :] >= 0)
    p_win = masked_softmax(s_win, win_valid)
    o_win = jnp.einsum('bhgnqk,bnkhd->bnqhgd', p_win, v_band.astype(jnp.float32)).reshape(b, s, hk, g, d)

    gates = jax.nn.sigmoid(gate_logits.astype(jnp.float32)).reshape(b, s, hk, g, 3)
    o = gates[..., 0:1] * o_cmp + gates[..., 1:2] * o_sel + gates[..., 2:3] * o_win
    return o.reshape(b, s, NSA_DIM)


def gated_deltanet(qkv, z, a, beta_logit, conv_w, a_log, dt_bias, norm_w):
    b, s, c3 = qkv.shape
    h, dk, c = DN_HEADS, DN_HEAD_DIM, DN_CHUNK
    n = s // c
    qkv = lax.conv_general_dilated(qkv, conv_w.astype(qkv.dtype), window_strides=(1,), padding=[(CONV_K - 1, 0)],
                                   dimension_numbers=('NWC', 'WIO', 'NWC'), feature_group_count=c3)
    qkv = jax.nn.silu(qkv.astype(jnp.float32))
    q, k, v = [t.reshape(b, s, h, dk) for t in jnp.split(qkv, 3, axis=-1)]
    q = l2norm(q) * dk ** -0.5
    k = l2norm(k)
    beta = jax.nn.sigmoid(beta_logit.astype(jnp.float32))
    gdec = -jnp.exp(a_log.astype(jnp.float32)) * jax.nn.softplus(a.astype(jnp.float32) + dt_bias.astype(jnp.float32))

    def chunks(t):
        return t.reshape(b, n, c, h, -1).transpose(0, 3, 1, 2, 4)

    q, k, v = chunks(q), chunks(k), chunks(v)
    beta = chunks(beta[..., None])[..., 0]
    gc = jnp.cumsum(chunks(gdec[..., None])[..., 0], axis=-1)
    lower_incl = np.tril(np.ones((c, c), dtype=bool))
    strict = np.tril(np.ones((c, c), dtype=bool), -1)
    decay = jnp.exp(jnp.where(lower_incl, gc[..., :, None] - gc[..., None, :], -jnp.inf))
    kb = k * beta[..., None]
    lmat = jnp.where(strict, jnp.einsum('bhnid,bhnjd->bhnij', kb, k) * decay, 0.0)
    eye = jnp.eye(c, dtype=jnp.float32)
    tinv = lax.linalg.triangular_solve(eye + lmat, jnp.broadcast_to(eye, lmat.shape), left_side=True, lower=True)
    u = tinv @ (v * beta[..., None])
    w = tinv @ (kb * jnp.exp(gc)[..., None])
    attn = jnp.einsum('bhnid,bhnjd->bhnij', q, k) * decay
    g_last = gc[..., -1]
    k_dec = k * jnp.exp(g_last[..., None] - gc)[..., None]
    q_dec = q * jnp.exp(gc)[..., None]

    def step(state, xs):
        q_i, k_i, u_i, w_i, attn_i, gl_i = xs
        v_new = u_i - jnp.einsum('bhck,bhkv->bhcv', w_i, state)
        o_i = jnp.einsum('bhck,bhkv->bhcv', q_i, state) + jnp.einsum('bhij,bhjv->bhiv', attn_i, v_new)
        state = state * jnp.exp(gl_i)[..., None, None] + jnp.einsum('bhck,bhcv->bhkv', k_i, v_new)
        return state, o_i

    xs = tuple(jnp.moveaxis(t, 2, 0) for t in (q_dec, k_dec, u, w, attn, g_last))
    state0 = jnp.zeros((b, h, dk, dk), jnp.float32)
    _, o = lax.scan(step, state0, xs)
    o = o.transpose(1, 0, 3, 2, 4).reshape(b, s, h, dk)
    o = rms_norm(o, norm_w) * jax.nn.silu(z.astype(jnp.float32).reshape(b, s, h, dk))
    return o.reshape(b, s, DN_DIM)


def setup_inputs(seed: int = 0) -> dict:
    key = jax.random.key(seed)
    ks = jax.random.split(key, 24)

    def nrm(k, shape, fan_in):
        return jax.random.normal(k, shape, jnp.float32) * fan_in ** -0.5

    def gain(k, shape):
        return 1.0 + 0.02 * jax.random.normal(k, shape, jnp.float32)

    dt = jnp.exp(jax.random.uniform(ks[5], (DEPTH, DN_HEADS), jnp.float32, math.log(1e-3), math.log(1e-1)))
    return {
        'x': jax.random.normal(ks[0], (BATCH, SEQ, D_MODEL), jnp.float32),
        'norm1_w': gain(ks[1], (DEPTH, D_MODEL)),
        'w_in': nrm(ks[2], (DEPTH, D_MODEL, N_IN), D_MODEL),
        'conv_w': nrm(ks[3], (DEPTH, CONV_K, 1, 3 * DN_DIM), CONV_K),
        'a_log': jnp.log(jax.random.uniform(ks[4], (DEPTH, DN_HEADS), jnp.float32, 1.0, 16.0)),
        'dt_bias': dt + jnp.log(-jnp.expm1(-dt)),
        'dn_norm_w': gain(ks[6], (DEPTH, DN_HEAD_DIM)),
        'cmp_pe_k': 0.02 * jax.random.normal(ks[7], (DEPTH, CMP_BLOCK, HEAD_DIM), jnp.float32),
        'cmp_w1_k': nrm(ks[8], (DEPTH, CMP_BLOCK * HEAD_DIM, HEAD_DIM), CMP_BLOCK * HEAD_DIM),
        'cmp_w2_k': nrm(ks[9], (DEPTH, HEAD_DIM, HEAD_DIM), HEAD_DIM),
        'cmp_pe_v': 0.02 * jax.random.normal(ks[10], (DEPTH, CMP_BLOCK, HEAD_DIM), jnp.float32),
        'cmp_w1_v': nrm(ks[11], (DEPTH, CMP_BLOCK * HEAD_DIM, HEAD_DIM), CMP_BLOCK * HEAD_DIM),
        'cmp_w2_v': nrm(ks[12], (DEPTH, HEAD_DIM, HEAD_DIM), HEAD_DIM),
        'w_up_nsa': nrm(ks[13], (DEPTH, NSA_DIM, D_MODEL), NSA_DIM),
        'w_up_dn': nrm(ks[14], (DEPTH, DN_DIM, D_MODEL), DN_DIM),
        'w_o': nrm(ks[15], (DEPTH, D_MODEL, D_MODEL), D_MODEL),
        'norm2_w': gain(ks[16], (DEPTH, D_MODEL)),
        'w_ffn_gate': nrm(ks[17], (DEPTH, D_MODEL, D_FF), D_MODEL),
        'w_ffn_up': nrm(ks[18], (DEPTH, D_MODEL, D_FF), D_MODEL),
        'w_ffn_down': nrm(ks[19], (DEPTH, D_FF, D_MODEL), D_FF),
        'norm_f_w': gain(ks[20], (D_MODEL,)),
    }


def reference(x, norm1_w, w_in, conv_w, a_log, dt_bias, dn_norm_w, cmp_pe_k, cmp_w1_k, cmp_w2_k,
              cmp_pe_v, cmp_w1_v, cmp_w2_v, w_up_nsa, w_up_dn, w_o, norm2_w, w_ffn_gate, w_ffn_up,
              w_ffn_down, norm_f_w):
    b, s, _ = x.shape
    cos, sin = rope_tables(s)
    for l in range(DEPTH):
        h = rms_norm(x, norm1_w[l])
        proj = h @ w_in[l]
        nsa_q, nsa_kv, nsa_g, dn_qkv, dn_z, dn_a, dn_b, merge_g = jnp.split(proj, split_points(), axis=-1)
        q = apply_rope(nsa_q.reshape(b, s, NSA_HEADS, HEAD_DIM), cos, sin)
        o_nsa = nsa_mixer(q, nsa_kv, nsa_g, cmp_pe_k[l], cmp_w1_k[l], cmp_w2_k[l],
                          cmp_pe_v[l], cmp_w1_v[l], cmp_w2_v[l], cos, sin).astype(x.dtype)
        o_dn = gated_deltanet(dn_qkv, dn_z, dn_a, dn_b, conv_w[l], a_log[l], dt_bias[l], dn_norm_w[l]).astype(x.dtype)
        g_nsa, g_dn = jnp.split(jax.nn.sigmoid(merge_g), 2, axis=-1)
        mixed = g_nsa * (o_nsa @ w_up_nsa[l]) + g_dn * (o_dn @ w_up_dn[l])
        x = x + mixed @ w_o[l]
        h2 = rms_norm(x, norm2_w[l])
        x = x + (jax.nn.silu(h2 @ w_ffn_gate[l]) * (h2 @ w_ffn_up[l])) @ w_ffn_down[l]
    return rms_norm(x, norm_f_w)
```

```cpp
#include <hip/hip_runtime.h>
#include <hip/hip_cooperative_groups.h>
#include <cstdio>
namespace cg = cooperative_groups;

#define LAS __attribute__((address_space(3)))
#define DI __device__ __forceinline__
typedef unsigned short bf16_t;
typedef short bf16x8 __attribute__((ext_vector_type(8)));
typedef short s16x4 __attribute__((ext_vector_type(4)));
typedef float f32x2 __attribute__((ext_vector_type(2)));
typedef float f32x4 __attribute__((ext_vector_type(4)));
typedef float f32x16 __attribute__((ext_vector_type(16)));
typedef unsigned u32x2 __attribute__((ext_vector_type(2)));
typedef unsigned u32x4 __attribute__((ext_vector_type(4)));
typedef __bf16 bfv2 __attribute__((ext_vector_type(2)));

constexpr int T_TOK = 16384, SEQ = 2048, DM = 2048, DFF = 5632;
constexpr int NIN_P = 11008, NGU_P = 11264;
constexpr float EPS = 1e-6f;

DI unsigned pk2(float a, float b) { f32x2 v = {a, b}; bfv2 r = __builtin_convertvector(v, bfv2); return __builtin_bit_cast(unsigned, r); }
DI float bf2f(bf16_t b) { return __uint_as_float(((unsigned)b) << 16); }
DI float bflo(unsigned u) { return __uint_as_float(u << 16); }
DI float bfhi(unsigned u) { return __uint_as_float(u & 0xffff0000u); }
DI bf16_t f2bf(float f) { return (bf16_t)(pk2(f, 0.f) & 0xffffu); }
DI float fexp2(float x) { return __builtin_amdgcn_exp2f(x); }
DI float fexp(float x) { return __builtin_amdgcn_exp2f(x * 1.4426950408889634f); }
DI float frcp(float x) { return __builtin_amdgcn_rcpf(x); }
DI float sigmoidf_(float x) { return frcp(1.f + fexp(-x)); }
DI float siluf_(float x) { return x * sigmoidf_(x); }
DI f32x16 mfma32(bf16x8 a, bf16x8 b, f32x16 c) { return __builtin_amdgcn_mfma_f32_32x32x16_bf16(a, b, c, 0, 0, 0); }
DI s16x4 tr_read(LAS const unsigned char* p) { return __builtin_amdgcn_ds_read_tr16_b64_v4i16((LAS s16x4*)p); }
DI bf16x8 cat8(s16x4 a, s16x4 b) { return __builtin_shufflevector(a, b, 0, 1, 2, 3, 4, 5, 6, 7); }
DI bf16x8 lds_b128(LAS const unsigned char* p) { return *(LAS const bf16x8*)p; }
DI LAS unsigned char* olds(LAS unsigned char* l) { unsigned z = 0; asm volatile("" : "+v"(z)); return l + z; }
DI int otid() { int t = threadIdx.x; asm volatile("" : "+v"(t)); return t; }
DI float xor32_sum(float v) { const unsigned u = __float_as_uint(v); auto r = __builtin_amdgcn_permlane32_swap(u, u, false, false); return __uint_as_float(r[0]) + __uint_as_float(r[1]); }
DI f32x16 zero16() { f32x16 z; for (int i = 0; i < 16; ++i) z[i] = 0.f; return z; }

struct Params {
    const float *x, *norm1_w, *w_in, *conv_w, *a_log, *dt_bias, *dn_norm_w, *cmp_pe_k, *cmp_w1_k, *cmp_w2_k, *cmp_pe_v, *cmp_w1_v, *cmp_w2_v,
        *w_up_nsa, *w_up_dn, *w_o, *norm2_w, *w_ffn_gate, *w_ffn_up, *w_ffn_down, *norm_f_w;
    float* out;
    bf16_t *Wt_in, *Wt_gu, *Wt_dn, *Wt_o, *Wt_upn, *Wt_upd, *W1t_k, *W1t_v, *W2t_k, *W2t_v;
    bf16_t *h, *qbuf, *kvbuf, *dnqkv, *dnz, *mg, *onsa, *odn, *mixed, *act, *kc, *vc;
    float *small, *rcos, *rsin, *onsa_f32, *dn_gc, *rowss;
    bf16_t *dn_q, *dn_k, *dn_u, *dn_w, *dn_at;
    unsigned* ctr; unsigned* bar;
};

namespace pg8 {
constexpr int BM = 256, BK = 64, HALF = 128, HTB = HALF * BK * 2, STAGE_BYTES = 8 * HTB, NXCD = 8, WGM = 8;
DI int lds_byte(int r, int c) { const int st = (r >> 4) * 2 + (c >> 5), rr = r & 15, cc = c & 31, ob = rr * 64 + cc * 2; return st * 1024 + (ob ^ (((ob >> 9) & 1) << 5)); }
DI void stage_rc(int b, int& R, int& C) { const int st = b / 1024, sb = b % 1024, swz = sb ^ (((sb >> 9) & 1) << 5); R = (st >> 1) * 16 + swz / 64; C = (st & 1) * 32 + (swz % 64) / 2; }
DI int perm32(int rho) { const int n = rho >> 4, i = rho & 15; return 8 * (i >> 2) + 4 * n + (i & 3); }
struct Unit { int pm, pn; };
struct Gemm { const bf16_t* A; const bf16_t* Bt; int M, N, K; };
struct StaticOrder {
    int nM, nN, nwg, G, c;
    DI void init(int M, int N, int G_, int c_) { nM = M / BM; nN = N / BM; nwg = nM * nN; G = G_; c = c_; }
    DI bool next(int i, Unit& u) const {
        const long L = (long)i * G + c; if (L >= nwg) return false;
        int wgid = (int)L; { const int q = nwg / NXCD, r = nwg % NXCD, xcd = wgid % NXCD, off = wgid / NXCD; wgid = (xcd < r ? xcd * (q + 1) : r * (q + 1) + (xcd - r) * q) + off; }
        const int nig = WGM * nN, gid = wgid / nig, fm = gid * WGM, gsz = (nM - fm) < WGM ? (nM - fm) : WGM;
        u.pm = fm + ((wgid % nig) % gsz); u.pn = (wgid % nig) / gsz; return true;
    }
};

template <class Epi>
DI void gemm_phase(LAS unsigned char* lds, const Gemm g, const StaticOrder& S, const Epi& E) {
    const int tid = otid(), wid = __builtin_amdgcn_readfirstlane(tid >> 6), lane = tid & 63, wr = wid >> 2, wc = wid & 3, fr = lane & 15, fq = lane >> 4;
    const int K = g.K, nt = K / BK;
    unsigned voffA[2], voffB[2];
#pragma unroll
    for (int i = 0; i < 2; ++i) { int R, C; stage_rc(tid * 16 + i * 8192, R, C); const int Rb = Epi::PERM ? ((R & ~31) + perm32(R & 31)) : R;
        voffA[i] = (unsigned)(R * K + C) * 2u; voffB[i] = (unsigned)(Rb * K + C) * 2u; }
    const size_t kstep = (size_t)(BK * 2);
    const size_t hstep = (size_t)HALF * K * 2;
    const size_t tstep = 2 * hstep;
    const unsigned ldsw = (unsigned)wid * 1024u;
    const int aoff = lds_byte(wr * 64 + fr, fq * 8), boff = lds_byte(wc * 32 + fr, fq * 8);
#define PG8_SA(b, h) (((b) * 2 + (h)) * HTB)
#define PG8_SB(b, h) ((4 + (b) * 2 + (h)) * HTB)
#define PG8_STAGE(bufoff, gbase, voff) do { _Pragma("unroll") for (int _i = 0; _i < 2; ++_i) \
        __builtin_amdgcn_global_load_lds((const unsigned*)((const char*)(gbase) + (voff)[_i]), (LAS unsigned*)(lds + (bufoff) + ldsw + _i * 8192), 16, 0, 0); } while (0)
#define PG8_LDA(dst, b, h) do { _Pragma("unroll") for (int m = 0; m < 4; ++m) _Pragma("unroll") for (int k = 0; k < 2; ++k) dst[m][k] = *(const LAS bf16x8*)(lds + PG8_SA(b, h) + aoff + m * 2048 + k * 1024); } while (0)
#define PG8_LDB(dst, b, h) do { _Pragma("unroll") for (int n = 0; n < 2; ++n) _Pragma("unroll") for (int k = 0; k < 2; ++k) dst[n][k] = *(const LAS bf16x8*)(lds + PG8_SB(b, h) + boff + n * 2048 + k * 1024); } while (0)
#define PG8_MMA(ai, bj, At, Bt) do { __builtin_amdgcn_s_setprio(1); _Pragma("unroll") for (int m = 0; m < 4; ++m) _Pragma("unroll") for (int n = 0; n < 2; ++n) _Pragma("unroll") for (int k = 0; k < 2; ++k) \
        acc[ai][bj][m][n] = __builtin_amdgcn_mfma_f32_16x16x32_bf16(Bt[n][k], At[m][k], acc[ai][bj][m][n], 0, 0, 0); __builtin_amdgcn_s_setprio(0); } while (0)
#define PG8_WAIT_V(n) asm volatile("s_waitcnt vmcnt(" #n ")" ::: "memory")
#define PG8_WAIT_L(n) asm volatile("s_waitcnt lgkmcnt(" #n ")" ::: "memory")
#define PG8_BAR __builtin_amdgcn_s_barrier()
#define PG8_SCHED __builtin_amdgcn_sched_barrier(0)
    Unit cur, nxt; int ui = 0;
    if (!S.next(0, cur)) return;
    f32x4 acc[2][2][4][2];
#pragma unroll
    for (int a = 0; a < 2; ++a)
#pragma unroll
        for (int b = 0; b < 2; ++b)
#pragma unroll
            for (int m = 0; m < 4; ++m)
#pragma unroll
                for (int n = 0; n < 2; ++n) acc[a][b][m][n] = (f32x4){0.f, 0.f, 0.f, 0.f};
    bf16x8 At[4][2], B0[2][2], B1[2][2];
    const char* cA = (const char*)g.A + (size_t)cur.pm * tstep; const char* cB = (const char*)g.Bt + (size_t)cur.pn * tstep;
    PG8_STAGE(PG8_SB(0, 0), cB, voffB); PG8_STAGE(PG8_SA(0, 0), cA, voffA); PG8_STAGE(PG8_SB(0, 1), cB + hstep, voffB); PG8_STAGE(PG8_SA(0, 1), cA + hstep, voffA);
    if (wr == 1) PG8_BAR;
    PG8_WAIT_V(4); PG8_BAR;
    PG8_STAGE(PG8_SB(1, 0), cB + kstep, voffB); PG8_STAGE(PG8_SA(1, 0), cA + kstep, voffA); PG8_STAGE(PG8_SB(1, 1), cB + hstep + kstep, voffB);
    PG8_WAIT_V(6); PG8_BAR;
    for (;;) {
        const bool has_next = S.next(ui + 1, nxt);
        const char* nA = has_next ? (const char*)g.A + (size_t)nxt.pm * tstep : cA; const char* nB = has_next ? (const char*)g.Bt + (size_t)nxt.pn * tstep : cB;
        for (int t = 0; t < nt; t += 2) {
            const bool last = (t == nt - 2);
            const char* a1 = cA + (size_t)(t + 1) * kstep;
            const char* a2 = last ? nA : cA + (size_t)(t + 2) * kstep; const char* b2 = last ? nB : cB + (size_t)(t + 2) * kstep;
            const char* a3 = a2 + kstep; const char* b3 = b2 + kstep;
            PG8_LDB(B0, 0, 0); PG8_SCHED; PG8_LDA(At, 0, 0); PG8_STAGE(PG8_SA(1, 1), a1 + hstep, voffA);
            PG8_WAIT_L(8); PG8_BAR; PG8_WAIT_L(0); PG8_MMA(0, 0, At, B0); PG8_BAR; PG8_SCHED;
            PG8_LDB(B1, 0, 1); PG8_STAGE(PG8_SB(0, 0), b2, voffB);
            PG8_BAR; PG8_WAIT_L(0); PG8_MMA(0, 1, At, B1); PG8_BAR;
            PG8_LDA(At, 0, 1); PG8_STAGE(PG8_SA(0, 0), a2, voffA);
            PG8_BAR; PG8_WAIT_L(0); PG8_MMA(1, 0, At, B0); PG8_BAR; PG8_SCHED;
            PG8_STAGE(PG8_SB(0, 1), b2 + hstep, voffB);
            PG8_WAIT_V(6); PG8_BAR; PG8_MMA(1, 1, At, B1); PG8_BAR;
            PG8_LDB(B0, 1, 0); PG8_SCHED; PG8_LDA(At, 1, 0); PG8_STAGE(PG8_SA(0, 1), a2 + hstep, voffA);
            PG8_WAIT_L(8); PG8_BAR; PG8_WAIT_L(0); PG8_MMA(0, 0, At, B0); PG8_BAR; PG8_SCHED;
            PG8_LDB(B1, 1, 1); PG8_STAGE(PG8_SB(1, 0), b3, voffB);
            PG8_BAR; PG8_WAIT_L(0); PG8_MMA(0, 1, At, B1); PG8_BAR;
            PG8_LDA(At, 1, 1); PG8_STAGE(PG8_SA(1, 0), a3, voffA);
            PG8_BAR; PG8_WAIT_L(0); PG8_MMA(1, 0, At, B0); PG8_BAR; PG8_SCHED;
            PG8_STAGE(PG8_SB(1, 1), b3 + hstep, voffB);
            PG8_WAIT_V(6); PG8_BAR; PG8_MMA(1, 1, At, B1); PG8_BAR;
        }
        E(acc, cur, wr, wc, fr, fq);
        if (!has_next) break;
#pragma unroll
        for (int a = 0; a < 2; ++a)
#pragma unroll
            for (int b = 0; b < 2; ++b)
#pragma unroll
                for (int m = 0; m < 4; ++m)
#pragma unroll
                    for (int n = 0; n < 2; ++n) acc[a][b][m][n] = (f32x4){0.f, 0.f, 0.f, 0.f};
        cur = nxt; cA = nA; cB = nB; ++ui;
    }
    PG8_WAIT_V(0);
    if (wr == 0) PG8_BAR;
    PG8_BAR;
#undef PG8_SA
#undef PG8_SB
#undef PG8_STAGE
#undef PG8_LDA
#undef PG8_LDB
#undef PG8_MMA
#undef PG8_WAIT_V
#undef PG8_WAIT_L
#undef PG8_BAR
#undef PG8_SCHED
}
}
using pg8::Unit;

typedef f32x4 AccT[2][2][4][2];

struct EpiInProj {
    static constexpr bool PERM = true;
    bf16_t *qbuf, *kvbuf, *dnqkv, *dnz, *mg; float* small; const float *rcos, *rsin;
    DI void operator()(const AccT& acc, const Unit& u, int wr, int wc, int fr, int fq) const {
        const int pn = u.pn; const int row0 = u.pm * 256 + wr * 64 + fr; const int cl = wc * 32 + 8 * fq;
        if (pn == 42) {
            if (wc < 2) {
#pragma unroll
                for (int ai = 0; ai < 2; ++ai)
#pragma unroll
                    for (int m = 0; m < 4; ++m) { float* rp = small + (size_t)(row0 + ai * 128 + m * 16) * 64 + cl;
                        *(f32x4*)(rp) = acc[ai][0][m][0]; *(f32x4*)(rp + 4) = acc[ai][0][m][1]; }
            }
            return;
        }
        bf16_t* dst; int ld, cbase; bool rope = false;
        if (pn < 4) { dst = qbuf; ld = 1024; cbase = pn * 256; rope = true; }
        else if (pn < 10) { dst = kvbuf; ld = 1536; cbase = (pn - 4) * 256; rope = ((pn - 4) & 1) == 0; }
        else if (pn < 22) { dst = dnqkv; ld = 3072; cbase = (pn - 10) * 256; }
        else if (pn < 26) { dst = dnz; ld = 1024; cbase = (pn - 22) * 256; }
        else { dst = mg; ld = 4096; cbase = (pn - 26) * 256; }
        if (rope) {
            const int i4 = 4 * (4 * wc + fq);
            f32x4 invr;
#pragma unroll
            for (int e = 0; e < 4; ++e) invr[e] = fexp2(-(float)(2 * (i4 + e)) * (13.287712379549449f / 128.0f)) * 0.15915494309189535f;
#pragma unroll
            for (int ai = 0; ai < 2; ++ai)
#pragma unroll
                for (int m = 0; m < 4; ++m) {
                    const int row = row0 + ai * 128 + m * 16; const int t = row & (SEQ - 1);
                    f32x4 c, s;
#pragma unroll
                    for (int e = 0; e < 4; ++e) { float rev = (float)t * invr[e]; rev = rev - floorf(rev); c[e] = __builtin_amdgcn_cosf(rev); s[e] = __builtin_amdgcn_sinf(rev); }
#pragma unroll
                    for (int bj = 0; bj < 2; ++bj) {
                        const f32x4 x1 = acc[ai][bj][m][0], x2 = acc[ai][bj][m][1];
                        const f32x4 o1 = x1 * c - x2 * s, o2 = x2 * c + x1 * s;
                        bf16_t* rp = dst + (size_t)row * ld + cbase + bj * 128 + i4;
                        u32x2 w1 = {pk2(o1[0], o1[1]), pk2(o1[2], o1[3])}, w2 = {pk2(o2[0], o2[1]), pk2(o2[2], o2[3])};
                        *(u32x2*)rp = w1; *(u32x2*)(rp + 64) = w2;
                    }
                }
        } else {
#pragma unroll
            for (int ai = 0; ai < 2; ++ai)
#pragma unroll
                for (int m = 0; m < 4; ++m) {
                    bf16_t* rp = dst + (size_t)(row0 + ai * 128 + m * 16) * ld + cbase + cl;
#pragma unroll
                    for (int bj = 0; bj < 2; ++bj) { const f32x4 v0 = acc[ai][bj][m][0], v1 = acc[ai][bj][m][1];
                        u32x4 w = {pk2(v0[0], v0[1]), pk2(v0[2], v0[3]), pk2(v1[0], v1[1]), pk2(v1[2], v1[3])};
                        *(u32x4*)(rp + bj * 128) = w; }
                }
        }
    }
};

template <int PASS> struct EpiUp {
    static constexpr bool PERM = true;
    bf16_t* mixed; const bf16_t* mg; int gofs;
    DI void operator()(const AccT& acc, const Unit& u, int wr, int wc, int fr, int fq) const {
        const int row0 = u.pm * 256 + wr * 64 + fr; const int col0 = u.pn * 256 + wc * 32 + 8 * fq;
#pragma unroll
        for (int ai = 0; ai < 2; ++ai)
#pragma unroll
            for (int mh = 0; mh < 2; ++mh) {
                u32x4 gvv[2][2], pvv[2][2];
#pragma unroll
                for (int mm = 0; mm < 2; ++mm) { const size_t row = (size_t)(row0 + ai * 128 + (2 * mh + mm) * 16);
#pragma unroll
                    for (int bj = 0; bj < 2; ++bj) { const int col = col0 + bj * 128;
                        gvv[mm][bj] = *(const u32x4*)(mg + row * 4096 + gofs + col);
                        if (PASS == 1) pvv[mm][bj] = *(const u32x4*)(mixed + row * 2048 + col); } }
#pragma unroll
                for (int mm = 0; mm < 2; ++mm) { const size_t row = (size_t)(row0 + ai * 128 + (2 * mh + mm) * 16);
#pragma unroll
                    for (int bj = 0; bj < 2; ++bj) {
                        const int col = col0 + bj * 128; const u32x4 gv = gvv[mm][bj];
                        bf16_t* op = mixed + row * 2048 + col;
                        const f32x4 v0 = acc[ai][bj][2 * mh + mm][0], v1 = acc[ai][bj][2 * mh + mm][1];
                        float r[8];
                        r[0] = sigmoidf_(bflo(gv[0])) * v0[0]; r[1] = sigmoidf_(bfhi(gv[0])) * v0[1]; r[2] = sigmoidf_(bflo(gv[1])) * v0[2]; r[3] = sigmoidf_(bfhi(gv[1])) * v0[3];
                        r[4] = sigmoidf_(bflo(gv[2])) * v1[0]; r[5] = sigmoidf_(bfhi(gv[2])) * v1[1]; r[6] = sigmoidf_(bflo(gv[3])) * v1[2]; r[7] = sigmoidf_(bfhi(gv[3])) * v1[3];
                        if (PASS == 1) { const u32x4 pv = pvv[mm][bj];
                            r[0] += bflo(pv[0]); r[1] += bfhi(pv[0]); r[2] += bflo(pv[1]); r[3] += bfhi(pv[1]); r[4] += bflo(pv[2]); r[5] += bfhi(pv[2]); r[6] += bflo(pv[3]); r[7] += bfhi(pv[3]); }
                        u32x4 w = {pk2(r[0], r[1]), pk2(r[2], r[3]), pk2(r[4], r[5]), pk2(r[6], r[7])};
                        *(u32x4*)op = w;
                    } }
            }
    }
};

template <int ACCUM> struct EpiResF32 {
    static constexpr bool PERM = false;
    float* out; const float* resid;
    DI void operator()(const AccT& acc, const Unit& u, int wr, int wc, int fr, int fq) const {
        const int row0 = u.pm * 256 + wr * 64 + fr, col0 = u.pn * 256 + wc * 32 + 4 * fq;
        const float* src = ACCUM ? (const float*)out : resid;
#pragma unroll
        for (int ai = 0; ai < 2; ++ai)
#pragma unroll
            for (int mh = 0; mh < 2; ++mh) {
                f32x4 base[2][2][2];
#pragma unroll
                for (int mm = 0; mm < 2; ++mm) { const size_t ro = (size_t)(row0 + ai * 128 + (2 * mh + mm) * 16) * DM + col0;
#pragma unroll
                    for (int bj = 0; bj < 2; ++bj)
#pragma unroll
                        for (int n = 0; n < 2; ++n) base[mm][bj][n] = *(const f32x4*)(src + ro + bj * 128 + n * 16); }
#pragma unroll
                for (int mm = 0; mm < 2; ++mm) { const size_t ro = (size_t)(row0 + ai * 128 + (2 * mh + mm) * 16) * DM + col0;
#pragma unroll
                    for (int bj = 0; bj < 2; ++bj)
#pragma unroll
                        for (int n = 0; n < 2; ++n) *(f32x4*)(out + ro + bj * 128 + n * 16) = base[mm][bj][n] + acc[ai][bj][2 * mh + mm][n]; }
            }
    }
};

struct EpiWo {
    static constexpr bool PERM = false;
    float* out; const float* resid; bf16_t* xb; float* rowss;
    DI void operator()(const AccT& acc, const Unit& u, int wr, int wc, int fr, int fq) const {
        const int row0 = u.pm * 256 + wr * 64 + fr, col0 = u.pn * 256 + wc * 32 + 4 * fq;
#pragma unroll
        for (int ai = 0; ai < 2; ++ai)
#pragma unroll
            for (int mh = 0; mh < 2; ++mh) {
                f32x4 base[2][2][2];
#pragma unroll
                for (int mm = 0; mm < 2; ++mm) { const size_t ro = (size_t)(row0 + ai * 128 + (2 * mh + mm) * 16) * DM + col0;
#pragma unroll
                    for (int bj = 0; bj < 2; ++bj)
#pragma unroll
                        for (int n = 0; n < 2; ++n) base[mm][bj][n] = *(const f32x4*)(resid + ro + bj * 128 + n * 16); }
#pragma unroll
                for (int mm = 0; mm < 2; ++mm) { const int row = row0 + ai * 128 + (2 * mh + mm) * 16; const size_t ro = (size_t)row * DM + col0;
                    float ss = 0.f;
#pragma unroll
                    for (int bj = 0; bj < 2; ++bj)
#pragma unroll
                        for (int n = 0; n < 2; ++n) { const f32x4 v = base[mm][bj][n] + acc[ai][bj][2 * mh + mm][n];
                            *(f32x4*)(out + ro + bj * 128 + n * 16) = v;
                            u32x2 w = {pk2(v[0], v[1]), pk2(v[2], v[3])}; *(u32x2*)(xb + ro + bj * 128 + n * 16) = w;
                            ss += v[0] * v[0] + v[1] * v[1] + v[2] * v[2] + v[3] * v[3]; }
                    ss += __shfl_xor(ss, 16); ss += __shfl_xor(ss, 32);
                    if (fq == 0) atomicAdd(rowss + row, ss);
                }
            }
    }
};

struct EpiGU {
    static constexpr bool PERM = true;
    bf16_t* act; const float* rowss;
    DI void operator()(const AccT& acc, const Unit& u, int wr, int wc, int fr, int fq) const {
        const int row0 = u.pm * 256 + wr * 64 + fr; const int col0 = (u.pn * 256 + wc * 32 + 8 * fq) >> 1;
        float rs[2][4];
#pragma unroll
        for (int ai = 0; ai < 2; ++ai)
#pragma unroll
            for (int m = 0; m < 4; ++m) rs[ai][m] = rowss[row0 + ai * 128 + m * 16];
#pragma unroll
        for (int ai = 0; ai < 2; ++ai)
#pragma unroll
            for (int m = 0; m < 4; ++m) rs[ai][m] = rsqrtf(rs[ai][m] * (1.0f / DM) + EPS);
#pragma unroll
        for (int ai = 0; ai < 2; ++ai)
#pragma unroll
            for (int m = 0; m < 4; ++m) { bf16_t* rp = act + (size_t)(row0 + ai * 128 + m * 16) * DFF + col0; const float r = rs[ai][m];
#pragma unroll
                for (int bj = 0; bj < 2; ++bj) { const f32x4 gt = acc[ai][bj][m][0] * r, up = acc[ai][bj][m][1] * r;
                    u32x2 w = {pk2(siluf_(gt[0]) * up[0], siluf_(gt[1]) * up[1]), pk2(siluf_(gt[2]) * up[2], siluf_(gt[3]) * up[3])};
                    *(u32x2*)(rp + bj * 64) = w; } }
    }
};

DI float wave_sum(float v) {
#pragma unroll
    for (int o = 32; o >= 1; o >>= 1) v += __shfl_xor(v, o);
    return v;
}

__device__ void rmsnorm_rows(const float* __restrict__ x, const float* __restrict__ w, bf16_t* outb, float* outf, int nrows) {
    const int tid_ = otid(); const int lane = tid_ & 63; const int gw = blockIdx.x * 8 + (tid_ >> 6), nw = gridDim.x * 8;
    for (int row = gw; row < nrows; row += nw) {
        const f32x4* xr = (const f32x4*)(x + (size_t)row * DM);
        f32x4 v[8]; float ss = 0.f;
#pragma unroll
        for (int i = 0; i < 8; ++i) { v[i] = xr[lane + 64 * i]; ss += v[i][0] * v[i][0] + v[i][1] * v[i][1] + v[i][2] * v[i][2] + v[i][3] * v[i][3]; }
        ss = wave_sum(ss);
        const float r = rsqrtf(ss * (1.0f / DM) + EPS);
#pragma unroll
        for (int i = 0; i < 8; ++i) { const f32x4 wv = ((const f32x4*)w)[lane + 64 * i]; const f32x4 o = v[i] * r * wv;
            if (outb) { u32x2 pw = {pk2(o[0], o[1]), pk2(o[2], o[3])}; *(u32x2*)(outb + (size_t)row * DM + 4 * (lane + 64 * i)) = pw; }
            else { *(f32x4*)(outf + (size_t)row * DM + 4 * (lane + 64 * i)) = o; } }
    }
}

DI int rope_perm(int r) { const int i = r >> 3, j = r & 7; return j < 4 ? 4 * i + j : 64 + 4 * i + (j - 4); }
DI int src_in(int p) {
    if (p < 1024) return (p & ~127) + rope_perm(p & 127);
    if (p < 2560) { const int pp = p - 1024; const int grp = pp >> 8; if (!(grp & 1)) return 1024 + (pp & ~127) + rope_perm(pp & 127); return 1024 + pp; }
    if (p < 5632) return 2584 + (p - 2560);
    if (p < 6656) return 5656 + (p - 5632);
    if (p < 10752) return 6696 + (p - 6656);
    const int s = p - 10752;
    if (s < 24) return 2560 + s;
    if (s < 32) return 6680 + (s - 24);
    if (s < 40) return 6688 + (s - 32);
    return -1;
}

template <int MODE, int PW>
__device__ void transpose_tiles(const float* __restrict__ W, const float* __restrict__ W2, int K, int N, bf16_t* Wt, int Np, LAS float* tile, int t0, int tstep, int tend, const float* __restrict__ kscale = nullptr) {
    const int tid = otid(); const int nkt = K / 64;
    constexpr int PQ = PW / 4, KR = 512 / PQ;
    for (int tt = t0; tt < tend; tt += tstep) {
        const int pt = tt / nkt, kt = tt % nkt; const int p0 = pt * PW, k0 = kt * 64;
        { const int pl = (tid % PQ) * 4, kr = tid / PQ; const int p = p0 + pl; const float* src = W; int sc;
          if (MODE == 0) sc = p; else if (MODE == 1) sc = src_in(p); else { const int g8 = p >> 3, j = p & 7; sc = 4 * g8 + (j & 3); if (j >= 4) src = W2; }
          const float* sp = src + (size_t)(k0 + kr) * N + (sc >= 0 ? sc : 0);
          f32x4 v[64 / KR];
#pragma unroll
          for (int i = 0; i < 64 / KR; ++i) v[i] = *(const f32x4*)(sp + (size_t)(i * KR) * N);
#pragma unroll
          for (int i = 0; i < 64 / KR; ++i) { LAS float* tp = tile + (kr + i * KR) * (PW + 1) + pl; const bool ok = sc >= 0;
              const float ks = kscale ? kscale[k0 + kr + i * KR] : 1.f;
              tp[0] = ok ? v[i][0] * ks : 0.f; tp[1] = ok ? v[i][1] * ks : 0.f; tp[2] = ok ? v[i][2] * ks : 0.f; tp[3] = ok ? v[i][3] * ks : 0.f; } }
        __syncthreads();
        { const int kq = tid & 7, pr = tid >> 3;
#pragma unroll
          for (int ps = 0; ps < PW / 64; ++ps) { float v[8]; const int prr = pr + 64 * ps;
#pragma unroll
              for (int i = 0; i < 8; ++i) v[i] = tile[(8 * kq + i) * (PW + 1) + prr];
              u32x4 w = {pk2(v[0], v[1]), pk2(v[2], v[3]), pk2(v[4], v[5]), pk2(v[6], v[7])};
              *(u32x4*)(Wt + (size_t)(p0 + prr) * K + k0 + 8 * kq) = w; } }
        __syncthreads();
    }
}
template <int MODE, int PW>
__device__ void transpose_w(const float* __restrict__ W, const float* __restrict__ W2, int K, int N, bf16_t* Wt, int Np, LAS float* tile, int& tcount) {
    const int ntile = (K / 64) * (Np / PW);
    transpose_tiles<MODE, PW>(W, W2, K, N, Wt, Np, tile, ((int)blockIdx.x - tcount % (int)gridDim.x + (int)gridDim.x) % (int)gridDim.x, (int)gridDim.x, ntile);
    tcount += ntile;
}

__device__ void phase_prep(const Params& p, LAS unsigned char* lds) {
    if (blockIdx.x == 0 && threadIdx.x == 0) { p.ctr[0] = 0u; p.ctr[1] = 0u; }
    for (int i = blockIdx.x * 512 + threadIdx.x; i < T_TOK; i += gridDim.x * 512) p.rowss[i] = 0.f;
    rmsnorm_rows(p.x, p.norm1_w, p.h, nullptr, T_TOK);
    LAS float* tile = (LAS float*)lds; int tc = 0;
    transpose_w<1, 256>(p.w_in, nullptr, DM, 10792, p.Wt_in, NIN_P, tile, tc);
    transpose_w<0, 256>(p.w_o, nullptr, DM, DM, p.Wt_o, DM, tile, tc);
    transpose_w<0, 256>(p.w_up_nsa, nullptr, 1024, DM, p.Wt_upn, DM, tile, tc);
    transpose_w<0, 256>(p.w_up_dn, nullptr, 1024, DM, p.Wt_upd, DM, tile, tc);
    transpose_w<0, 128>(p.cmp_w1_k, nullptr, 4096, 128, p.W1t_k, 128, tile, tc);
    transpose_w<0, 128>(p.cmp_w1_v, nullptr, 4096, 128, p.W1t_v, 128, tile, tc);
    transpose_w<0, 128>(p.cmp_w2_k, nullptr, 128, 128, p.W2t_k, 128, tile, tc);
    transpose_w<0, 128>(p.cmp_w2_v, nullptr, 128, 128, p.W2t_v, 128, tile, tc);
}

DI float gelu_tanh(float x) { const float u = 0.7978845608028654f * (x + 0.044715f * x * x * x); const float e = fexp(2.f * u); return 0.5f * x * (2.f - 2.f * frcp(e + 1.f)); }

__device__ void phase_compress(const Params& p, LAS unsigned char* lds) {
    const int tid = otid(), wid = tid >> 6, lane = tid & 63, l32 = lane & 31, h = lane >> 5;
    const int kq = wid & 3, nh = wid >> 2;
    LAS float* red = (LAS float*)lds;
    LAS unsigned char* Hs = lds + 4 * 32 * 132 * 4;
    for (int item = blockIdx.x; item < 128; item += gridDim.x) {
        const int mt = item & 3, hk = (item >> 2) & 1, b = (item >> 3) & 7, kv = item >> 6;
        const bf16_t* W1t = kv ? p.W1t_v : p.W1t_k; const bf16_t* W2t = kv ? p.W2t_v : p.W2t_k; const float* pe = kv ? p.cmp_pe_v : p.cmp_pe_k;
        bf16_t* outp = (kv ? p.vc : p.kc) + (size_t)((b * 2 + hk) * 128) * 128;
        const int c = 32 * mt + l32;
        const bf16_t* abase = p.kvbuf + (size_t)(b * SEQ) * 1536 + kv * 256 + hk * 128 + 32 * kq + 8 * h;
        f32x16 acc[2]; acc[0] = zero16(); acc[1] = zero16();
#pragma unroll 4
        for (int li = 0; li < 32; ++li) {
            int tok = 16 * c + li; tok = tok > SEQ - 1 ? SEQ - 1 : tok;
#pragma unroll
            for (int s2 = 0; s2 < 2; ++s2) {
                const u32x4 av = *(const u32x4*)(abase + (size_t)tok * 1536 + 16 * s2);
                const f32x4 pe0 = *(const f32x4*)(pe + li * 128 + 32 * kq + 16 * s2 + 8 * h), pe1 = *(const f32x4*)(pe + li * 128 + 32 * kq + 16 * s2 + 8 * h + 4);
                u32x4 aw = {pk2(bflo(av[0]) + pe0[0], bfhi(av[0]) + pe0[1]), pk2(bflo(av[1]) + pe0[2], bfhi(av[1]) + pe0[3]),
                            pk2(bflo(av[2]) + pe1[0], bfhi(av[2]) + pe1[1]), pk2(bflo(av[3]) + pe1[2], bfhi(av[3]) + pe1[3])};
                const bf16x8 af = __builtin_bit_cast(bf16x8, aw);
#pragma unroll
                for (int n2 = 0; n2 < 2; ++n2) {
                    const bf16x8 bfr = *(const bf16x8*)(W1t + (size_t)(64 * nh + 32 * n2 + l32) * 4096 + li * 128 + 32 * kq + 16 * s2 + 8 * h);
                    acc[n2] = mfma32(af, bfr, acc[n2]);
                }
            }
        }
#pragma unroll
        for (int n2 = 0; n2 < 2; ++n2)
#pragma unroll
            for (int r = 0; r < 16; ++r) red[(kq * 32 + 8 * (r >> 2) + 4 * h + (r & 3)) * 132 + 64 * nh + 32 * n2 + l32] = acc[n2][r];
        __syncthreads();
        { const int row = tid >> 4, c8 = (tid & 15) * 8; float v[8];
#pragma unroll
          for (int i = 0; i < 8; ++i) { const int o = row * 132 + c8 + i; v[i] = gelu_tanh(red[o] + red[32 * 132 + o] + red[2 * 32 * 132 + o] + red[3 * 32 * 132 + o]); }
          u32x4 w = {pk2(v[0], v[1]), pk2(v[2], v[3]), pk2(v[4], v[5]), pk2(v[6], v[7])};
          *(LAS u32x4*)(Hs + row * 272 + c8 * 2) = w; }
        __syncthreads();
        if (wid < 4) {
            f32x16 o = zero16();
#pragma unroll
            for (int ks = 0; ks < 8; ++ks) {
                const bf16x8 af = lds_b128(Hs + l32 * 272 + (16 * ks + 8 * h) * 2);
                const bf16x8 bfr = *(const bf16x8*)(W2t + (size_t)(32 * wid + l32) * 128 + 16 * ks + 8 * h);
                o = mfma32(af, bfr, o);
            }
#pragma unroll
            for (int r = 0; r < 16; ++r) outp[(size_t)(32 * mt + 8 * (r >> 2) + 4 * h + (r & 3)) * 128 + 32 * wid + l32] = f2bf(o[r]);
        }
        __syncthreads();
    }
}

constexpr int KS = 272, VS = 320;
constexpr int L_K0 = 0, L_K1 = 17408, L_V0 = 34816, L_V1 = 55296, L_PART = 75776, L_MASK = 109568, L_Q = 131056;
constexpr float SC_LOG2E = 0.08838834764831845f * 1.4426950408889634f;

struct KVRegs { u32x4 k0, k1, v0, v1; };
DI void kv_load(KVRegs& r, const bf16_t* Kg, const bf16_t* Vg, int ld, int j, int tid) {
    const int r0 = tid >> 4, c16 = tid & 15;
    const size_t o0 = (size_t)(64 * j + r0) * ld + 8 * c16, o1 = o0 + (size_t)32 * ld;
    r.k0 = *(const u32x4*)(Kg + o0); r.k1 = *(const u32x4*)(Kg + o1); r.v0 = *(const u32x4*)(Vg + o0); r.v1 = *(const u32x4*)(Vg + o1);
}
DI void kv_store(const KVRegs& r, LAS unsigned char* Kl, LAS unsigned char* Vl, int tid) {
    const int r0 = tid >> 4, c16 = tid & 15;
    *(LAS u32x4*)(Kl + r0 * KS + 16 * c16) = r.k0; *(LAS u32x4*)(Kl + (r0 + 32) * KS + 16 * c16) = r.k1;
    *(LAS u32x4*)(Vl + r0 * VS + 16 * c16) = r.v0; *(LAS u32x4*)(Vl + (r0 + 32) * VS + 16 * c16) = r.v1;
}
DI void qk_block(LAS const unsigned char* Kl, const bf16x8 (&qf)[8], int lane, f32x16& s0, f32x16& s1) {
    const int l32 = lane & 31, h = lane >> 5;
    s0 = zero16(); s1 = zero16();
    LAS const unsigned char* kp = Kl + l32 * KS + 16 * h;
    bf16x8 A[2][4];
    A[0][0] = lds_b128(kp); A[0][1] = lds_b128(kp + 32 * KS); A[0][2] = lds_b128(kp + 32); A[0][3] = lds_b128(kp + 32 * KS + 32);
#pragma unroll
    for (int b = 0; b < 4; ++b) {
        if (b < 3) { A[(b + 1) & 1][0] = lds_b128(kp + 64 * (b + 1)); A[(b + 1) & 1][1] = lds_b128(kp + 32 * KS + 64 * (b + 1));
                     A[(b + 1) & 1][2] = lds_b128(kp + 64 * (b + 1) + 32); A[(b + 1) & 1][3] = lds_b128(kp + 32 * KS + 64 * (b + 1) + 32); }
        s0 = mfma32(A[b & 1][0], qf[2 * b], s0); s1 = mfma32(A[b & 1][1], qf[2 * b], s1);
        s0 = mfma32(A[b & 1][2], qf[2 * b + 1], s0); s1 = mfma32(A[b & 1][3], qf[2 * b + 1], s1);
    }
}
DI bf16x8 pack8(const f32x16& p, int q) {
    u32x4 w = {pk2(p[8 * q], p[8 * q + 1]), pk2(p[8 * q + 2], p[8 * q + 3]), pk2(p[8 * q + 4], p[8 * q + 5]), pk2(p[8 * q + 6], p[8 * q + 7])};
    return __builtin_bit_cast(bf16x8, w);
}
DI void pv_block(LAS const unsigned char* Vl, const bf16x8 (&pb)[4], int lane, f32x16 (&o)[4]) {
    const int h = lane >> 5;
    LAS const unsigned char* vp = Vl + (4 * h + ((lane & 15) >> 2)) * VS + (16 * ((lane >> 4) & 1) + 4 * (lane & 3)) * 2;
    s16x4 V[2][8];
#pragma unroll
    for (int dt = 0; dt < 4; ++dt) { V[0][2 * dt] = tr_read(vp + 64 * dt); V[0][2 * dt + 1] = tr_read(vp + 8 * VS + 64 * dt); }
#pragma unroll
    for (int kq = 0; kq < 4; ++kq) {
        if (kq < 3) {
#pragma unroll
            for (int dt = 0; dt < 4; ++dt) { V[(kq + 1) & 1][2 * dt] = tr_read(vp + (16 * (kq + 1)) * VS + 64 * dt); V[(kq + 1) & 1][2 * dt + 1] = tr_read(vp + (16 * (kq + 1) + 8) * VS + 64 * dt); }
        }
#pragma unroll
        for (int dt = 0; dt < 4; ++dt) o[dt] = mfma32(cat8(V[kq & 1][2 * dt], V[kq & 1][2 * dt + 1]), pb[kq], o[dt]);
    }
}
DI void softmax_block(f32x16& s0, f32x16& s1, int lo, int hi, int h, float& m, float& l, f32x16 (&o)[4], bf16x8 (&pb)[4]) {
    float mx = -1e30f;
    if (__any((lo > 0) || (hi < 63))) {
        const int lo2 = lo - 4 * h, hi2 = hi - 4 * h;
#pragma unroll
        for (int i = 0; i < 16; ++i) { const int k0 = 8 * (i >> 2) + (i & 3);
            s0[i] = (k0 >= lo2 && k0 <= hi2) ? s0[i] : -1e30f; s1[i] = (k0 + 32 >= lo2 && k0 + 32 <= hi2) ? s1[i] : -1e30f; }
    }
#pragma unroll
    for (int i = 0; i < 16; ++i) mx = fmaxf(mx, fmaxf(s0[i], s1[i]));
    mx = fmaxf(mx, __shfl_xor(mx, 32));
    const float mn = fmaxf(m, mx);
    const float alpha = fexp2((m - mn) * SC_LOG2E);
    const float mb = mn * SC_LOG2E;
    m = mn;
    float ps = 0.f;
#pragma unroll
    for (int i = 0; i < 16; ++i) { s0[i] = fexp2(s0[i] * SC_LOG2E - mb); s1[i] = fexp2(s1[i] * SC_LOG2E - mb); ps += s0[i] + s1[i]; }
    l = l * alpha + ps;
    if (__any(alpha != 1.0f)) {
#pragma unroll
        for (int dt = 0; dt < 4; ++dt) o[dt] = o[dt] * alpha;
    }
    pb[0] = pack8(s0, 0); pb[1] = pack8(s0, 1); pb[2] = pack8(s1, 0); pb[3] = pack8(s1, 1);
}

template <int MODE>
DI void branch_out(const f32x16 (&o)[4], float fac, float* of32, bf16_t* obf, int h) {
#pragma unroll
    for (int dt = 0; dt < 4; ++dt)
#pragma unroll
        for (int ig = 0; ig < 4; ++ig) {
            const int d0 = 32 * dt + 8 * ig + 4 * h;
            f32x4 v = {o[dt][4 * ig] * fac, o[dt][4 * ig + 1] * fac, o[dt][4 * ig + 2] * fac, o[dt][4 * ig + 3] * fac};
            if (MODE >= 1) v += *(const f32x4*)(of32 + d0);
            if (MODE <= 1) *(f32x4*)(of32 + d0) = v;
            if (MODE == 2) { u32x2 w = {pk2(v[0], v[1]), pk2(v[2], v[3])}; *(u32x2*)(obf + d0) = w; }
        }
}

template <int MODE>
DI void attn_stream(const bf16_t* Kg, const bf16_t* Vg, int jlo, int jhi, unsigned blockmask, unsigned mymask, int qb, int tl,
                    const bf16x8 (&qf)[8], f32x16 (&o)[4], float& m, float& l, LAS unsigned char* lds, int tid, int lane) {
    const int h = lane >> 5;
    int j = jlo;
    if (MODE == 1) { while (j <= jhi && !((blockmask >> j) & 1u)) ++j; }
    KVRegs kr;
    kv_load(kr, Kg, Vg, 1536, j, tid);
    kv_store(kr, lds + L_K0, lds + L_V0, tid);
    __syncthreads();
    int cur = 0;
    for (;;) {
        int jn = j + 1;
        if (MODE == 1) { while (jn <= jhi && !((blockmask >> jn) & 1u)) ++jn; }
        const bool hn = jn <= jhi;
        if (hn) kv_load(kr, Kg, Vg, 1536, jn, tid);
        LAS unsigned char* Kl = lds + (cur ? L_K1 : L_K0); LAS unsigned char* Vl = lds + (cur ? L_V1 : L_V0);
        f32x16 s0, s1; qk_block(Kl, qf, lane, s0, s1);
        int lo = 0, hi = 63;
        if (MODE == 1) { if (j == qb) hi = tl; if (!((mymask >> j) & 1u)) hi = -1; }
        else { if (j == qb - 8) lo = tl + 1; if (j == qb) hi = tl; }
        bf16x8 pb[4];
        softmax_block(s0, s1, lo, hi, h, m, l, o, pb);
        pv_block(Vl, pb, lane, o);
        if (!hn) break;
        kv_store(kr, lds + (cur ? L_K0 : L_K1), lds + (cur ? L_V0 : L_V1), tid);
        __syncthreads();
        cur ^= 1; j = jn;
    }
    __syncthreads();
}

__device__ void nsa_item(const Params& p, int b, int hk, int qb, LAS unsigned char* lds) {
    const int tid = otid(), wid = tid >> 6, lane = tid & 63, l32 = lane & 31, h = lane >> 5;
    const int g = wid >> 1, tl = (wid & 1) * 32 + l32, t = qb * 64 + tl; const size_t row = (size_t)b * SEQ + t; const int head = hk * 4 + g;
    bf16x8 qf[8];
    { const bf16_t* qp = p.qbuf + row * 1024 + head * 128 + 8 * h;
#pragma unroll
      for (int ks = 0; ks < 8; ++ks) qf[ks] = *(const bf16x8*)(qp + 16 * ks); }
    const float* glp = p.small + row * 64 + head * 3;
    const float gate0 = sigmoidf_(glp[0]), gate1 = sigmoidf_(glp[1]), gate2 = sigmoidf_(glp[2]);
    float* of32 = p.onsa_f32 + row * 1024 + head * 128; bf16_t* obf = p.onsa + row * 1024 + head * 128;
    f32x16 o[4];
    const int ncb = (qb >= 16) ? 2 : 1;
    {
        const bf16_t* kcg = p.kc + (size_t)((b * 2 + hk) * 128) * 128; const bf16_t* vcg = p.vc + (size_t)((b * 2 + hk) * 128) * 128;
        KVRegs kr;
        kv_load(kr, kcg, vcg, 128, 0, tid); kv_store(kr, lds + L_K0, lds + L_V0, tid);
        if (ncb == 2) { kv_load(kr, kcg, vcg, 128, 1, tid); kv_store(kr, lds + L_K1, lds + L_V1, tid); }
        __syncthreads();
        const int cmax = (t >= 31) ? min(126, (t - 31) >> 4) : -1;
        f32x16 s[4];
        qk_block(lds + L_K0, qf, lane, s[0], s[1]);
        if (ncb == 2) qk_block(lds + L_K1, qf, lane, s[2], s[3]); else { s[2] = zero16(); s[3] = zero16(); }
        float mx = -1e20f;
#pragma unroll
        for (int q = 0; q < 4; ++q)
#pragma unroll
            for (int i = 0; i < 16; ++i) { const int c = 32 * q + 8 * (i >> 2) + 4 * h + (i & 3); s[q][i] = (c <= cmax) ? s[q][i] : -1e30f; mx = fmaxf(mx, s[q][i]); }
        mx = fmaxf(mx, __shfl_xor(mx, 32));
        float ps = 0.f;
#pragma unroll
        for (int q = 0; q < 4; ++q)
#pragma unroll
            for (int i = 0; i < 16; ++i) { s[q][i] = fexp2((s[q][i] - mx) * SC_LOG2E); ps += s[q][i]; }
        ps += __shfl_xor(ps, 32);
        const float inv = ps > 0.f ? frcp(ps) : 0.f;
        if (ncb == 2) {
            LAS float* part = (LAS float*)(lds + L_PART) + (g * 64 + tl) * 33;
#pragma unroll
            for (int q = 0; q < 4; ++q)
#pragma unroll
                for (int ig = 0; ig < 4; ++ig) part[8 * q + 2 * ig + h] = (s[q][4 * ig] + s[q][4 * ig + 1] + s[q][4 * ig + 2] + 0.5f * s[q][4 * ig + 3]) * inv;
            __syncthreads();
#pragma unroll
            for (int q = 0; q < 4; ++q)
#pragma unroll
                for (int ig = 0; ig < 4; ++ig) { const int jj = 8 * q + 2 * ig + h + 1; if (jj < 32) part[jj] += 0.5f * s[q][4 * ig + 3] * inv; }
        }
#pragma unroll
        for (int dt = 0; dt < 4; ++dt) o[dt] = zero16();
        { bf16x8 pb[4]; pb[0] = pack8(s[0], 0); pb[1] = pack8(s[0], 1); pb[2] = pack8(s[1], 0); pb[3] = pack8(s[1], 1); pv_block(lds + L_V0, pb, lane, o); }
        if (ncb == 2) { bf16x8 pb[4]; pb[0] = pack8(s[2], 0); pb[1] = pack8(s[2], 1); pb[2] = pack8(s[3], 0); pb[3] = pack8(s[3], 1); pv_block(lds + L_V1, pb, lane, o); }
        branch_out<0>(o, gate0 * inv, of32, obf, h);
        __syncthreads();
    }
    unsigned mymask, blockmask;
    if (qb >= 16) {
        LAS unsigned* masks = (LAS unsigned*)(lds + L_MASK);
        {
            const int ttl = tid >> 3, jq = tid & 7;
            LAS const float* pp = (LAS const float*)(lds + L_PART) + ttl * 33;
            float imp[32];
#pragma unroll
            for (int j = 0; j < 32; ++j) { float v = pp[j] + pp[64 * 33 + j] + pp[2 * 64 * 33 + j] + pp[3 * 64 * 33 + j];
                if (j == 0 || j == qb || j == qb - 1) v = 1e9f; else if (j > qb) v = -1e9f;
                imp[j] = v; }
            unsigned bits = 0u;
#pragma unroll
            for (int q = 0; q < 4; ++q) {
                const int j = 4 * jq + q; float vj = 0.f;
#pragma unroll
                for (int jj = 0; jj < 32; ++jj) vj = (jj == j) ? imp[jj] : vj;
                int rank = 0;
#pragma unroll
                for (int jj = 0; jj < 32; ++jj) rank += (imp[jj] > vj || (imp[jj] == vj && jj < j)) ? 1 : 0;
                if (rank < 16) bits |= 1u << j;
            }
            bits |= __shfl_xor(bits, 1); bits |= __shfl_xor(bits, 2); bits |= __shfl_xor(bits, 4);
            if (jq == 0) masks[ttl] = bits;
        }
        __syncthreads();
        mymask = masks[tl]; blockmask = 0u;
        for (int i = 0; i < 64; ++i) blockmask |= masks[i];
    } else { mymask = (2u << qb) - 1u; blockmask = mymask; }
    {
        float m = -1e20f, l = 0.f;
#pragma unroll
        for (int dt = 0; dt < 4; ++dt) o[dt] = zero16();
        const bf16_t* Kg = p.kvbuf + (size_t)(b * SEQ) * 1536 + 2 * 256 + hk * 128; const bf16_t* Vg = Kg + 256;
        attn_stream<1>(Kg, Vg, 0, qb, blockmask, mymask, qb, tl, qf, o, m, l, lds, tid, lane);
        l += __shfl_xor(l, 32);
        branch_out<1>(o, gate1 * frcp(l), of32, obf, h);
    }
    {
        float m = -1e20f, l = 0.f;
#pragma unroll
        for (int dt = 0; dt < 4; ++dt) o[dt] = zero16();
        const bf16_t* Kg = p.kvbuf + (size_t)(b * SEQ) * 1536 + 4 * 256 + hk * 128; const bf16_t* Vg = Kg + 256;
        attn_stream<2>(Kg, Vg, max(0, qb - 8), qb, 0u, 0u, qb, tl, qf, o, m, l, lds, tid, lane);
        l += __shfl_xor(l, 32);
        branch_out<2>(o, gate2 * frcp(l), of32, obf, h);
    }
}

constexpr int D_QS = 0, D_KS = 17408, D_VS = 34816, D_WS = 52224, D_LS = 69632, D_AT = 87040, D_MISC = 130048;
constexpr int STS = 264, VTS = 136, ATS = 144;

struct PrepRegs { u32x4 xr[3][4][2]; float w4[4]; float sa, sb; };
DI void dn_prep_issue(const Params& p, int item, PrepRegs& R, int tid) {
    const int b = item & 7, hh = (item >> 3) & 7, n = 31 - (item >> 6);
    const int r = tid >> 3, cc = tid & 7; const int tok = 64 * n + r; const size_t grow = (size_t)b * SEQ + tok;
#pragma unroll
    for (int seg = 0; seg < 3; ++seg)
#pragma unroll
        for (int tp = 0; tp < 4; ++tp) {
            const int tk = tok - 3 + tp; const size_t rr = tk >= 0 ? grow - 3 + tp : grow;
            const bf16_t* xp = p.dnqkv + rr * 3072 + seg * 1024 + hh * 128 + 16 * cc;
            R.xr[seg][tp][0] = *(const u32x4*)xp; R.xr[seg][tp][1] = *(const u32x4*)(xp + 8);
        }
    const int t384 = tid < 384 ? tid : 0;
#pragma unroll
    for (int tp = 0; tp < 4; ++tp) R.w4[tp] = p.conv_w[(size_t)tp * 3072 + (t384 >> 7) * 1024 + hh * 128 + (t384 & 127)];
    const int tt = tid >= 448 ? tid - 448 : 0; const size_t gr = (size_t)b * SEQ + 64 * n + tt;
    R.sa = p.small[gr * 64 + 24 + hh]; R.sb = p.small[gr * 64 + 32 + hh];
}
__device__ int dn_prep_item(const Params& p, int item, PrepRegs& R, LAS unsigned char* lds_in) {
    const int b = item & 7, hh = (item >> 3) & 7, n = 31 - (item >> 6); int next_item;
    const int tid = otid(), wid = tid >> 6, lane = tid & 63, l32 = lane & 31, h = lane >> 5;
    LAS unsigned char* lds = olds(lds_in);
    LAS float* gcs = (LAS float*)(lds + D_MISC); LAS float* betas = gcs + 64; LAS float* Ls = (LAS float*)olds(lds_in + D_LS);
    const float neg_ea = -__expf(p.a_log[hh]); const float dtb = p.dt_bias[hh];
    {
        {
            const int r = tid >> 3, cc = tid & 7; const int tok = 64 * n + r;
            LAS int* slot = (LAS int*)(lds + L_Q);
            if (tid == 0) *slot = (int)atomicAdd(p.ctr + 1, 1u);
            LAS float* wl = (LAS float*)(lds + D_WS);
            if (tid < 384) {
#pragma unroll
                for (int tp = 0; tp < 4; ++tp) wl[tp * 384 + tid] = R.w4[tp];
            }
            if (tid >= 448) {
                const int tt = tid - 448;
                const float a = R.sa + dtb, bl = R.sb;
                const float sp = a > 20.f ? a : log1pf(__expf(a));
                float gsum = neg_ea * sp;
#pragma unroll
                for (int o = 1; o < 64; o <<= 1) { const float u = __shfl_up(gsum, o); if (lane >= o) gsum += u; }
                gcs[tt] = gsum; betas[tt] = sigmoidf_(bl);
            }
            __syncthreads();
            next_item = *slot;
#pragma unroll
            for (int seg = 0; seg < 3; ++seg) {
                float y[16];
#pragma unroll
                for (int i = 0; i < 16; ++i) y[i] = 0.f;
#pragma unroll
                for (int tp = 0; tp < 4; ++tp) {
                    const float msk = (tok - 3 + tp >= 0) ? 1.f : 0.f;
                    const u32x4 xa = R.xr[seg][tp][0], xb = R.xr[seg][tp][1];
                    LAS const float* wp = wl + tp * 384 + seg * 128 + 16 * cc;
                    const f32x4 w0 = *(LAS const f32x4*)wp * msk, w1 = *(LAS const f32x4*)(wp + 4) * msk, w2 = *(LAS const f32x4*)(wp + 8) * msk, w3 = *(LAS const f32x4*)(wp + 12) * msk;
                    y[0] += bflo(xa[0]) * w0[0]; y[1] += bfhi(xa[0]) * w0[1]; y[2] += bflo(xa[1]) * w0[2]; y[3] += bfhi(xa[1]) * w0[3];
                    y[4] += bflo(xa[2]) * w1[0]; y[5] += bfhi(xa[2]) * w1[1]; y[6] += bflo(xa[3]) * w1[2]; y[7] += bfhi(xa[3]) * w1[3];
                    y[8] += bflo(xb[0]) * w2[0]; y[9] += bfhi(xb[0]) * w2[1]; y[10] += bflo(xb[1]) * w2[2]; y[11] += bfhi(xb[1]) * w2[3];
                    y[12] += bflo(xb[2]) * w3[0]; y[13] += bfhi(xb[2]) * w3[1]; y[14] += bflo(xb[3]) * w3[2]; y[15] += bfhi(xb[3]) * w3[3];
                }
                float ss = 0.f;
#pragma unroll
                for (int i = 0; i < 16; ++i) { y[i] = siluf_(y[i]); ss += y[i] * y[i]; }
                float sc = 1.f;
                if (seg < 2) { ss += __shfl_xor(ss, 1); ss += __shfl_xor(ss, 2); ss += __shfl_xor(ss, 4); sc = rsqrtf(ss + EPS); if (seg == 0) sc *= 0.08838834764831845f; }
                LAS unsigned char* dst = lds + (seg == 0 ? D_QS : (seg == 1 ? D_KS : D_VS)) + r * 272 + cc * 32;
                u32x4 wa = {pk2(y[0] * sc, y[1] * sc), pk2(y[2] * sc, y[3] * sc), pk2(y[4] * sc, y[5] * sc), pk2(y[6] * sc, y[7] * sc)};
                u32x4 wb = {pk2(y[8] * sc, y[9] * sc), pk2(y[10] * sc, y[11] * sc), pk2(y[12] * sc, y[13] * sc), pk2(y[14] * sc, y[15] * sc)};
                *(LAS u32x4*)dst = wa; *(LAS u32x4*)(dst + 16) = wb;
            }
            if (next_item < 2048) dn_prep_issue(p, next_item, R, tid);
        }
        __syncthreads();
        {
            const int isq = wid >> 2, bm = (wid >> 1) & 1, bn = wid & 1;
            LAS const unsigned char* Ab = lds + (isq ? D_QS : D_KS) + (32 * bm + l32) * 272 + 16 * h;
            LAS const unsigned char* Bb = lds + D_KS + (32 * bn + l32) * 272 + 16 * h;
            f32x16 acc = zero16();
            if (bm >= bn) {
#pragma unroll
                for (int ks = 0; ks < 8; ++ks) acc = mfma32(lds_b128(Ab + 32 * ks), lds_b128(Bb + 32 * ks), acc);
            }
            const int j = 32 * bn + l32; const float gj = gcs[j];
            const int ib = 32 * bm + 4 * h;
            LAS const float* gci = gcs + ib; LAS const float* bti = betas + ib;
            LAS unsigned char* atw = lds + D_AT + ib * ATS + j * 2; LAS float* lsw = Ls + ib * 68 + j;
#pragma unroll
            for (int r = 0; r < 16; ++r) {
                const int ro = 8 * (r >> 2) + (r & 3); const int i = ib + ro;
                const float dec = fexp(fminf(gci[ro] - gj, 0.f));
                if (isq) { const float v = (i >= j) ? acc[r] * dec : 0.f; *(LAS bf16_t*)(atw + ro * ATS) = f2bf(v); }
                else { const float v = (i > j) ? acc[r] * dec * bti[ro] : 0.f; lsw[ro * 68] = v; }
            }
        }
        __syncthreads();
        {
            const int c = 32 * wid + l32; const bool isw = wid >= 4;
            LAS const unsigned char* src = lds + (isw ? D_KS : D_VS) + (c & 127) * 2 + (4 * h) * 272;
            LAS const float* bth = betas + 4 * h; LAS const float* gch = gcs + 4 * h;
            float xs[32];
#pragma unroll
            for (int sidx = 0; sidx < 32; ++sidx) { const int ro = 8 * (sidx >> 2) + (sidx & 3);
                const float bi = bth[ro]; const float f = isw ? bi * fexp(gch[ro]) : bi; xs[sidx] = bf2f(*(LAS const bf16_t*)(src + ro * 272)) * f; }
            LAS const float* Lh = Ls + 4 * h;
#pragma unroll
            for (int i = 1; i < 64; ++i) {
                float a0 = 0.f, a1 = 0.f, a2 = 0.f, a3 = 0.f;
#pragma unroll
                for (int jj = 0; jj < (i + 7) / 8; ++jj) { const f32x4 lv = *(LAS const f32x4*)(Lh + i * 68 + 8 * jj);
                    a0 += lv[0] * xs[4 * jj]; a1 += lv[1] * xs[4 * jj + 1]; a2 += lv[2] * xs[4 * jj + 2]; a3 += lv[3] * xs[4 * jj + 3]; }
                const float tot = xor32_sum((a0 + a1) + (a2 + a3));
                const int g4 = i >> 2; const int slot = 4 * (g4 >> 1) + (i & 3);
                xs[slot] = (h == (g4 & 1)) ? xs[slot] - tot : xs[slot];
            }
            LAS unsigned char* dst = lds + (isw ? D_WS : D_VS) + (c & 127) * 2 + (4 * h) * 272;
#pragma unroll
            for (int sidx = 0; sidx < 32; ++sidx) { const int ro = 8 * (sidx >> 2) + (sidx & 3); *(LAS bf16_t*)(dst + ro * 272) = f2bf(xs[sidx]); }
        }
        __syncthreads();
        const size_t chunk = (size_t)((b * 8 + hh) * 32 + n);
        { const int r0 = tid >> 4, c16 = tid & 15;
#pragma unroll
          for (int rg = 0; rg < 4; ++rg) {
              const int lo = rg == 0 ? D_QS : (rg == 1 ? D_KS : (rg == 2 ? D_VS : D_WS));
              bf16_t* gb = (rg == 0 ? p.dn_q : (rg == 1 ? p.dn_k : (rg == 2 ? p.dn_u : p.dn_w))) + chunk * 8192;
#pragma unroll
              for (int hf = 0; hf < 2; ++hf) { const int r = r0 + 32 * hf; *(u32x4*)(gb + r * 128 + 8 * c16) = *(LAS const u32x4*)(lds + lo + r * 272 + 16 * c16); }
          }
          { const int r = tid >> 3, c8 = tid & 7; *(u32x4*)(p.dn_at + chunk * 4096 + r * 64 + 8 * c8) = *(LAS const u32x4*)(lds + D_AT + r * ATS + 16 * c8); }
          if (tid < 64) p.dn_gc[chunk * 64 + tid] = gcs[tid];
        }
    }
    __syncthreads();
    return next_item;
}

constexpr int S_WS = 0, S_QS = 17408, S_KS = 34816, S_US = 52224, S_AT = 69632, S_ST = 78848, S_MISC = 112640, S_OS = 112896;

struct DnRegs { u32x4 w0, w1, q0, q1, k0, k1, u0, u1, at, z0, z1; float gc; };
DI void dn_fetch(DnRegs& r, const Params& p, int b, int hh, int n, int tid) {
    const size_t chunk = (size_t)((b * 8 + hh) * 32 + n);
    const int r0 = tid >> 4, c16 = tid & 15; const size_t o0 = chunk * 8192 + r0 * 128 + 8 * c16, o1 = o0 + 32 * 128;
    r.w0 = *(const u32x4*)(p.dn_w + o0); r.w1 = *(const u32x4*)(p.dn_w + o1); r.q0 = *(const u32x4*)(p.dn_q + o0); r.q1 = *(const u32x4*)(p.dn_q + o1);
    r.k0 = *(const u32x4*)(p.dn_k + o0); r.k1 = *(const u32x4*)(p.dn_k + o1); r.u0 = *(const u32x4*)(p.dn_u + o0); r.u1 = *(const u32x4*)(p.dn_u + o1);
    r.at = *(const u32x4*)(p.dn_at + chunk * 4096 + (tid >> 3) * 64 + 8 * (tid & 7));
    r.gc = p.dn_gc[chunk * 64 + (tid & 63)];
    const bf16_t* zp = p.dnz + ((size_t)b * SEQ + 64 * n + (tid >> 3)) * 1024 + hh * 128 + 16 * (tid & 7);
    r.z0 = *(const u32x4*)zp; r.z1 = *(const u32x4*)(zp + 8);
}
DI void dn_fill(const DnRegs& r, LAS unsigned char* lds, int tid) {
    const int r0 = tid >> 4, c16 = tid & 15; const int a0 = r0 * 272 + 16 * c16, a1 = a0 + 32 * 272;
    *(LAS u32x4*)(lds + S_WS + a0) = r.w0; *(LAS u32x4*)(lds + S_WS + a1) = r.w1; *(LAS u32x4*)(lds + S_QS + a0) = r.q0; *(LAS u32x4*)(lds + S_QS + a1) = r.q1;
    *(LAS u32x4*)(lds + S_KS + a0) = r.k0; *(LAS u32x4*)(lds + S_KS + a1) = r.k1; *(LAS u32x4*)(lds + S_US + a0) = r.u0; *(LAS u32x4*)(lds + S_US + a1) = r.u1;
    *(LAS u32x4*)(lds + S_AT + (tid >> 3) * ATS + 16 * (tid & 7)) = r.at;
    if (tid < 64) ((LAS float*)(lds + S_MISC))[tid] = r.gc;
}

__device__ void dn_scan(const Params& p, int b, int hh, LAS unsigned char* lds_in) {
    const int tid = otid(), wid = tid >> 6, lane = tid & 63, l32 = lane & 31, h = lane >> 5;
    LAS unsigned char* lds = lds_in;
    for (int i = tid; i < 128 * STS / 4; i += 512) ((LAS unsigned*)(lds + S_ST))[i] = 0u;
    f32x16 st[2]; st[0] = zero16(); st[1] = zero16();
    const int mtk = wid >> 1, ntv0 = 2 * (wid & 1);
    const int mt = wid >> 2, nt = wid & 3;
    DnRegs nx;
    dn_fetch(nx, p, b, hh, 0, tid);
    dn_fill(nx, lds, tid);
    u32x4 zc0 = nx.z0, zc1 = nx.z1;
    __syncthreads();
    for (int n = 0; n < 32; ++n) {
        lds = olds(lds_in);
        LAS const float* gcs = (LAS const float*)(lds + S_MISC);
        if (n < 31) dn_fetch(nx, p, b, hh, n + 1, tid);
        const float glast = gcs[63];
        f32x16 vn = zero16();
        {
            LAS const unsigned char* Ab = lds + S_WS + (32 * mt + l32) * 272 + 16 * h;
            LAS const unsigned char* Bb = lds + S_ST + (32 * nt + l32) * STS + 16 * h;
#pragma unroll
            for (int ks = 0; ks < 8; ++ks) vn = mfma32(lds_b128(Ab + 32 * ks), lds_b128(Bb + 32 * ks), vn);
            LAS const unsigned char* up = lds + S_US + (32 * mt + 4 * h) * 272 + (32 * nt + l32) * 2;
#pragma unroll
            for (int r = 0; r < 16; ++r) { const int ro = 8 * (r >> 2) + (r & 3); vn[r] = bf2f(*(LAS const bf16_t*)(up + ro * 272)) - vn[r]; }
        }
        __syncthreads();
        {
            const int ib = 32 * mt + 4 * h;
            LAS const float* gci = gcs + ib;
            LAS unsigned char* w1p = lds + S_US + (32 * nt + l32) * VTS + ib * 2; LAS unsigned char* w2p = lds + S_WS + (32 * nt + l32) * VTS + ib * 2;
#pragma unroll
            for (int ig = 0; ig < 4; ++ig) {
                const float e0 = fexp(glast - gci[8 * ig]), e1 = fexp(glast - gci[8 * ig + 1]), e2 = fexp(glast - gci[8 * ig + 2]), e3 = fexp(glast - gci[8 * ig + 3]);
                u32x2 w = {pk2(vn[4 * ig], vn[4 * ig + 1]), pk2(vn[4 * ig + 2], vn[4 * ig + 3])};
                u32x2 ws = {pk2(vn[4 * ig] * e0, vn[4 * ig + 1] * e1), pk2(vn[4 * ig + 2] * e2, vn[4 * ig + 3] * e3)};
                *(LAS u32x2*)(w1p + 16 * ig) = w; *(LAS u32x2*)(w2p + 16 * ig) = ws;
            }
        }
        __syncthreads();
        f32x16 oa = zero16();
        {
            LAS const unsigned char* Ab = lds + S_QS + (32 * mt + l32) * 272 + 16 * h;
            LAS const unsigned char* Bb = lds + S_ST + (32 * nt + l32) * STS + 16 * h;
#pragma unroll
            for (int ks = 0; ks < 8; ++ks) oa = mfma32(lds_b128(Ab + 32 * ks), lds_b128(Bb + 32 * ks), oa);
            { LAS const float* gci = gcs + 32 * mt + 4 * h;
#pragma unroll
              for (int r = 0; r < 16; ++r) oa[r] *= fexp(gci[8 * (r >> 2) + (r & 3)]); }
            LAS const unsigned char* A2 = lds + S_AT + (32 * mt + l32) * ATS + 16 * h;
            LAS const unsigned char* B2 = lds + S_US + (32 * nt + l32) * VTS + 16 * h;
#pragma unroll
            for (int ks = 0; ks < 4; ++ks) oa = mfma32(lds_b128(A2 + 32 * ks), lds_b128(B2 + 32 * ks), oa);
            const float eg = fexp(glast);
            st[0] = st[0] * eg; st[1] = st[1] * eg;
            LAS const unsigned char* kp = lds + S_KS + (8 * h + ((lane & 15) >> 2)) * 272 + (32 * mtk + 16 * ((lane >> 4) & 1) + 4 * (lane & 3)) * 2;
#pragma unroll
            for (int s = 0; s < 4; ++s) {
                const bf16x8 af = cat8(tr_read(kp + (16 * s) * 272), tr_read(kp + (16 * s + 4) * 272));
#pragma unroll
                for (int q = 0; q < 2; ++q) {
                    const bf16x8 bfr = lds_b128(lds + S_WS + (32 * (ntv0 + q) + l32) * VTS + (16 * s + 8 * h) * 2);
                    st[q] = mfma32(af, bfr, st[q]);
                }
            }
        }
        __syncthreads();
        {
            { LAS unsigned char* osw = lds + S_OS + (32 * mt + 4 * h) * 272 + (32 * nt + l32) * 2;
#pragma unroll
              for (int r = 0; r < 16; ++r) *(LAS bf16_t*)(osw + (8 * (r >> 2) + (r & 3)) * 272) = f2bf(oa[r]); }
#pragma unroll
            for (int q = 0; q < 2; ++q) { LAS unsigned char* sp = lds + S_ST + (32 * (ntv0 + q) + l32) * STS + (32 * mtk + 4 * h) * 2;
#pragma unroll
                for (int ig = 0; ig < 4; ++ig) {
                    u32x2 w = {pk2(st[q][4 * ig], st[q][4 * ig + 1]), pk2(st[q][4 * ig + 2], st[q][4 * ig + 3])};
                    *(LAS u32x2*)(sp + 16 * ig) = w; } }
            if (n < 31) dn_fill(nx, lds, tid);
        }
        __syncthreads();
        {
            const int r = tid >> 3, cc = tid & 7; const size_t grow = (size_t)b * SEQ + 64 * n + r;
            const u32x4 oa4 = *(LAS const u32x4*)(lds + S_OS + r * 272 + cc * 32), ob4 = *(LAS const u32x4*)(lds + S_OS + r * 272 + cc * 32 + 16);
            float y[16] = {bflo(oa4[0]), bfhi(oa4[0]), bflo(oa4[1]), bfhi(oa4[1]), bflo(oa4[2]), bfhi(oa4[2]), bflo(oa4[3]), bfhi(oa4[3]),
                           bflo(ob4[0]), bfhi(ob4[0]), bflo(ob4[1]), bfhi(ob4[1]), bflo(ob4[2]), bfhi(ob4[2]), bflo(ob4[3]), bfhi(ob4[3])};
            float ss = 0.f;
#pragma unroll
            for (int i = 0; i < 16; ++i) ss += y[i] * y[i];
            ss += __shfl_xor(ss, 1); ss += __shfl_xor(ss, 2); ss += __shfl_xor(ss, 4);
            const float rs = rsqrtf(ss * (1.0f / 128.0f) + EPS);
            const float z[16] = {bflo(zc0[0]), bfhi(zc0[0]), bflo(zc0[1]), bfhi(zc0[1]), bflo(zc0[2]), bfhi(zc0[2]), bflo(zc0[3]), bfhi(zc0[3]),
                                 bflo(zc1[0]), bfhi(zc1[0]), bflo(zc1[1]), bfhi(zc1[1]), bflo(zc1[2]), bfhi(zc1[2]), bflo(zc1[3]), bfhi(zc1[3])};
            const float* nw = p.dn_norm_w + 16 * cc;
#pragma unroll
            for (int i = 0; i < 16; ++i) y[i] = y[i] * rs * nw[i] * siluf_(z[i]);
            u32x4 wa = {pk2(y[0], y[1]), pk2(y[2], y[3]), pk2(y[4], y[5]), pk2(y[6], y[7])}, wb = {pk2(y[8], y[9]), pk2(y[10], y[11]), pk2(y[12], y[13]), pk2(y[14], y[15])};
            bf16_t* op = p.odn + grow * 1024 + hh * 128 + 16 * cc;
            *(u32x4*)op = wa; *(u32x4*)(op + 8) = wb;
            zc0 = nx.z0; zc1 = nx.z1;
        }
    }
    __syncthreads();
}

__device__ void phase_mixers(const Params& p, LAS unsigned char* lds) {
    LAS int* slot = (LAS int*)(lds + L_Q);
    for (;;) {
        __syncthreads();
        if (threadIdx.x == 0) *slot = (int)atomicAdd(p.ctr, 1u);
        __syncthreads();
        const int item = *slot;
        if (item >= 64 + 512 + 264) break;
        if (item < 64) dn_scan(p, item >> 3, item & 7, lds);
        else if (item < 576) { const int e = item - 64; const int qb = 31 - (e >> 4); nsa_item(p, (e >> 1) & 7, e & 1, qb, lds); }
        else {
            const int f = item - 576;
            if (f < 176) transpose_tiles<2, 256>(p.w_ffn_gate, p.w_ffn_up, DM, DFF, p.Wt_gu, NGU_P, (LAS float*)lds, f * 8, 1, f * 8 + 8, p.norm2_w);
            else transpose_tiles<0, 256>(p.w_ffn_down, nullptr, DFF, DM, p.Wt_dn, DM, (LAS float*)lds, (f - 176) * 8, 1, (f - 176) * 8 + 8);
        }
    }
}


#define XB_TMO      128
#define XB_XCNT(j)  (256  + 64 * (j))
#define XB_XSUB(j)  (1280 + 64 * (j))
#define XB_XGEN(j)  (2304 + 64 * (j))
#define XB_TOP      3328
#define XB_TOPGEN   3392
#define XCD_BAR_WORDS 3456
#define XB_SPIN_CAP (1u << 18)
DI unsigned xb_ld(unsigned* p)              { return __hip_atomic_load(p, __ATOMIC_RELAXED, __HIP_MEMORY_SCOPE_AGENT); }
DI unsigned xb_add(unsigned* p, unsigned v) { return __hip_atomic_fetch_add(p, v, __ATOMIC_RELAXED, __HIP_MEMORY_SCOPE_AGENT); }
DI unsigned xb_xcc_id() { return (unsigned)__builtin_amdgcn_s_getreg((3 << 11) | 20) & 0xFu; }
#define XB_SPIN(cond, bar) do { unsigned _sp = 0; while (cond) { __builtin_amdgcn_s_sleep(1); \
    if ((++_sp & 255u) == 0u) { if (xb_ld(&(bar)[XB_TMO])) break; if (_sp > XB_SPIN_CAP) { atomicAdd(&(bar)[XB_TMO], 1u); break; } } } } while (0)
struct XcdBarrier { unsigned* bar; unsigned x; volatile LAS unsigned* st; };
DI XcdBarrier xcd_barrier_post(unsigned* bar, volatile LAS unsigned* st) {
    XcdBarrier b; b.bar = bar; b.x = xb_xcc_id(); b.st = st;
    if (threadIdx.x == 0) (void)xb_add(&bar[XB_XCNT(b.x)], 1u);
    return b;
}
DI void xcd_barrier_complete(unsigned* bar, unsigned x, unsigned& nloc, unsigned& nx) {
    const unsigned G = gridDim.x * gridDim.y * gridDim.z;
    unsigned sum, cnt, mine, sp = 0u;
    for (;;) {
        sum = 0u; cnt = 0u; mine = 0u;
#pragma unroll
        for (unsigned j = 0; j < 16; ++j) { const unsigned c = xb_ld(&bar[XB_XCNT(j)]); sum += c; cnt += (c > 0u) ? 1u : 0u; mine = (j == x) ? c : mine; }
        if (sum == G) break;
        __builtin_amdgcn_s_sleep(1);
        if ((++sp & 255u) == 0u) { if (xb_ld(&bar[XB_TMO])) break; if (sp > XB_SPIN_CAP) { atomicAdd(&bar[XB_TMO], 1u); break; } }
    }
    nloc = mine > 0u ? mine : 1u; nx = cnt > 0u ? cnt : 1u;
}
DI void xcd_barrier_leader(unsigned* bar, unsigned x, volatile LAS unsigned* st) {
    __builtin_amdgcn_s_waitcnt(0);
    unsigned nloc = st[0], nx = st[1];
    if (nloc == 0u) { xcd_barrier_complete(bar, x, nloc, nx); st[0] = nloc; st[1] = nx; }
    const unsigned old = xb_add(&bar[XB_XSUB(x)], 1u);
    const unsigned gen = old / nloc;
    if (old + 1u == (gen + 1u) * nloc) {
        __builtin_amdgcn_fence(__ATOMIC_RELEASE, "agent");
        asm volatile("s_waitcnt vmcnt(0)" ::: "memory");
        const unsigned og = xb_add(&bar[XB_TOP], 1u);
        const unsigned tg = og / nx;
        if (og + 1u == (tg + 1u) * nx) xb_add(&bar[XB_TOPGEN], 1u);
        else XB_SPIN(xb_ld(&bar[XB_TOPGEN]) == tg, bar);
        __builtin_amdgcn_fence(__ATOMIC_ACQUIRE, "agent");
        xb_add(&bar[XB_XGEN(x)], 1u);
        asm volatile("s_waitcnt vmcnt(0)" ::: "memory");
    } else {
        XB_SPIN(xb_ld(&bar[XB_XGEN(x)]) == gen, bar);
        __builtin_amdgcn_fence(__ATOMIC_ACQUIRE, "agent");
        asm volatile("s_waitcnt vmcnt(0)" ::: "memory");
    }
}
DI void xcd_barrier(const XcdBarrier& b) {
    asm volatile("s_waitcnt vmcnt(0)" ::: "memory");
    __syncthreads();
    if (threadIdx.x == 0) xcd_barrier_leader(b.bar, b.x, b.st);
    __syncthreads();
}

__global__ __launch_bounds__(512, 2) void hybrid_block_megakernel(Params p) {
    extern __shared__ __attribute__((aligned(16))) unsigned char shm[];
    LAS unsigned char* lds = (LAS unsigned char*)shm;
    cg::grid_group grid = cg::this_grid();
    const int G = gridDim.x, c = blockIdx.x;
    __shared__ uint4 xb_words;
    if (threadIdx.x == 0) xb_words = make_uint4(0u, 0u, 0u, 0u);
    if (blockIdx.x == 0) { for (int i = threadIdx.x; i < XCD_BAR_WORDS; i += 512) p.bar[i] = 0u; }
    phase_prep(p, lds);
    grid.sync();
    const XcdBarrier xbar = xcd_barrier_post(p.bar, (volatile LAS unsigned*)&xb_words);
    { pg8::Gemm g{p.h, p.Wt_in, T_TOK, NIN_P, DM}; pg8::StaticOrder S; S.init(g.M, g.N, G, c);
      EpiInProj E{p.qbuf, p.kvbuf, p.dnqkv, p.dnz, p.mg, p.small, p.rcos, p.rsin}; pg8::gemm_phase(lds, g, S, E); }
    xcd_barrier(xbar);
    phase_compress(p, lds);
    { LAS int* slot = (LAS int*)(lds + L_Q);
      __syncthreads();
      if (threadIdx.x == 0) *slot = (int)atomicAdd(p.ctr + 1, 1u);
      __syncthreads();
      int item = *slot;
      PrepRegs R;
      if (item < 2048) dn_prep_issue(p, item, R, otid());
      while (item < 2048) item = dn_prep_item(p, item, R, lds);
    }
    xcd_barrier(xbar);
    phase_mixers(p, lds);
    xcd_barrier(xbar);
    { pg8::Gemm g{p.onsa, p.Wt_upn, T_TOK, DM, 1024}; pg8::StaticOrder S; S.init(g.M, g.N, G, c); EpiUp<0> E{p.mixed, p.mg, 0}; pg8::gemm_phase(lds, g, S, E); }
    { pg8::Gemm g{p.odn, p.Wt_upd, T_TOK, DM, 1024}; pg8::StaticOrder S; S.init(g.M, g.N, G, c); EpiUp<1> E{p.mixed, p.mg, 2048}; pg8::gemm_phase(lds, g, S, E); }
    xcd_barrier(xbar);
    { pg8::Gemm g{p.mixed, p.Wt_o, T_TOK, DM, DM}; pg8::StaticOrder S; S.init(g.M, g.N, G, c); EpiWo E{p.out, p.x, p.h, p.rowss}; pg8::gemm_phase(lds, g, S, E); }
    xcd_barrier(xbar);
    { pg8::Gemm g{p.h, p.Wt_gu, T_TOK, NGU_P, DM}; pg8::StaticOrder S; S.init(g.M, g.N, G, c); EpiGU E{p.act, p.rowss}; pg8::gemm_phase(lds, g, S, E); }
    xcd_barrier(xbar);
    { pg8::Gemm g{p.act, p.Wt_dn, T_TOK, DM, DFF}; pg8::StaticOrder S; S.init(g.M, g.N, G, c); EpiResF32<1> E{p.out, nullptr}; pg8::gemm_phase(lds, g, S, E); }
    xcd_barrier(xbar);
    rmsnorm_rows(p.out, p.norm_f_w, nullptr, p.out, T_TOK);
}

extern "C" void kernel_launch(void* const* d_in, const int* in_sizes, int n_in, void* d_out, int out_size, void* d_ws, size_t ws_size, hipStream_t stream) {
    constexpr size_t kDynLds = 131072;
    static int grid_blocks = 0;
    if (!grid_blocks) {
        int dev = 0, cus = 0, per_cu = 0;
        hipGetDevice(&dev);
        hipDeviceGetAttribute(&cus, hipDeviceAttributeMultiprocessorCount, dev);
        hipFuncSetAttribute((const void*)hybrid_block_megakernel, hipFuncAttributeMaxDynamicSharedMemorySize, (int)kDynLds);
        hipOccupancyMaxActiveBlocksPerMultiprocessor(&per_cu, hybrid_block_megakernel, 512, kDynLds);
        if (per_cu < 1) per_cu = 1;
        grid_blocks = cus * 1;
        if (grid_blocks > cus * per_cu) grid_blocks = cus * per_cu;
    }
    Params p{};
    const float* const* in = (const float* const*)d_in;
    p.x = in[0]; p.norm1_w = in[1]; p.w_in = in[2]; p.conv_w = in[3]; p.a_log = in[4]; p.dt_bias = in[5]; p.dn_norm_w = in[6];
    p.cmp_pe_k = in[7]; p.cmp_w1_k = in[8]; p.cmp_w2_k = in[9]; p.cmp_pe_v = in[10]; p.cmp_w1_v = in[11]; p.cmp_w2_v = in[12];
    p.w_up_nsa = in[13]; p.w_up_dn = in[14]; p.w_o = in[15]; p.norm2_w = in[16]; p.w_ffn_gate = in[17]; p.w_ffn_up = in[18]; p.w_ffn_down = in[19]; p.norm_f_w = in[20];
    p.out = (float*)d_out;
    unsigned char* w = (unsigned char*)d_ws; size_t off = 0;
    auto take = [&](size_t bytes) { unsigned char* r = w + off; off += (bytes + 255) & ~(size_t)255; return r; };
    p.ctr = (unsigned*)take(256); p.bar = (unsigned*)take(XCD_BAR_WORDS * 4);
    p.dn_q = (bf16_t*)take((size_t)T_TOK * 1024 * 2); p.dn_k = (bf16_t*)take((size_t)T_TOK * 1024 * 2);
    p.Wt_o = (bf16_t*)take((size_t)DM * DM * 2); p.Wt_upn = (bf16_t*)take((size_t)DM * 1024 * 2); p.Wt_upd = (bf16_t*)take((size_t)DM * 1024 * 2);
    p.W1t_k = (bf16_t*)take((size_t)128 * 4096 * 2); p.W1t_v = (bf16_t*)take((size_t)128 * 4096 * 2); p.W2t_k = (bf16_t*)take(128 * 128 * 2); p.W2t_v = (bf16_t*)take(128 * 128 * 2);
    p.rcos = (float*)take((size_t)SEQ * 64 * 4); p.rsin = (float*)take((size_t)SEQ * 64 * 4);
    p.kc = (bf16_t*)take((size_t)16 * 128 * 128 * 2); p.vc = (bf16_t*)take((size_t)16 * 128 * 128 * 2);
    p.small = (float*)take((size_t)T_TOK * 64 * 4); p.rowss = (float*)take((size_t)T_TOK * 4);
    p.h = (bf16_t*)take((size_t)T_TOK * DM * 2);
    p.onsa = p.h; p.odn = p.h + (size_t)T_TOK * 1024;
    p.qbuf = (bf16_t*)take((size_t)T_TOK * 1024 * 2); p.kvbuf = (bf16_t*)take((size_t)T_TOK * 1536 * 2);
    p.mixed = p.qbuf;
    p.dnqkv = (bf16_t*)take((size_t)T_TOK * 3072 * 2); p.dnz = (bf16_t*)take((size_t)T_TOK * 1024 * 2); p.onsa_f32 = (float*)take((size_t)T_TOK * 1024 * 4);
    p.Wt_gu = p.dnqkv; p.Wt_dn = p.Wt_gu + (size_t)NGU_P * DM;
    p.mg = (bf16_t*)d_out;
    p.Wt_in = (bf16_t*)take((size_t)NIN_P * DM * 2 + 39321600);
    p.act = p.dnz;
    p.dn_u = p.Wt_in; p.dn_w = p.dn_u + (size_t)T_TOK * 1024; p.dn_at = p.dn_w + (size_t)T_TOK * 1024; p.dn_gc = (float*)(p.dn_at + (size_t)2048 * 4096);
    if (off > ws_size) { fprintf(stderr, "workspace too small: need %zu have %zu\n", off, ws_size); return; }
    void* args[] = {&p};
    hipError_t e = hipLaunchCooperativeKernel((void*)hybrid_block_megakernel, dim3(grid_blocks), dim3(512), args, kDynLds, stream);
    if (e != hipSuccess) fprintf(stderr, "cooperative launch failed: %s (grid %d)\n", hipGetErrorString(e), grid_blocks);
}
```

```cpp
#include <hip/hip_runtime.h>
#include <hip/hip_cooperative_groups.h>
#include <cstdio>
namespace cg = cooperative_groups;

#define LAS __attribute__((address_space(3)))
#define DI __device__ __forceinline__
typedef unsigned short bf16_t;
typedef short bf16x8 __attribute__((ext_vector_type(8)));
typedef short s16x4 __attribute__((ext_vector_type(4)));
typedef float f32x2 __attribute__((ext_vector_type(2)));
typedef float f32x4 __attribute__((ext_vector_type(4)));
typedef float f32x16 __attribute__((ext_vector_type(16)));
typedef unsigned u32x2 __attribute__((ext_vector_type(2)));
typedef unsigned u32x4 __attribute__((ext_vector_type(4)));
typedef __bf16 bfv2 __attribute__((ext_vector_type(2)));

constexpr int T_TOK = 16384, SEQ = 2048, DM = 2048, DFF = 5632;
constexpr int NIN_P = 11008, NGU_P = 11264;
constexpr float EPS = 1e-6f;

DI unsigned pk2(float a, float b) { f32x2 v = {a, b}; bfv2 r = __builtin_convertvector(v, bfv2); return __builtin_bit_cast(unsigned, r); }
DI float bf2f(bf16_t b) { return __uint_as_float(((unsigned)b) << 16); }
DI float bflo(unsigned u) { return __uint_as_float(u << 16); }
DI float bfhi(unsigned u) { return __uint_as_float(u & 0xffff0000u); }
DI bf16_t f2bf(float f) { return (bf16_t)(pk2(f, 0.f) & 0xffffu); }
DI float fexp2(float x) { return __builtin_amdgcn_exp2f(x); }
DI float fexp(float x) { return __builtin_amdgcn_exp2f(x * 1.4426950408889634f); }
DI float frcp(float x) { return __builtin_amdgcn_rcpf(x); }
DI float sigmoidf_(float x) { return frcp(1.f + fexp(-x)); }
DI float siluf_(float x) { return x * sigmoidf_(x); }
DI f32x16 mfma32(bf16x8 a, bf16x8 b, f32x16 c) { return __builtin_amdgcn_mfma_f32_32x32x16_bf16(a, b, c, 0, 0, 0); }
DI s16x4 tr_read(LAS const unsigned char* p) { return __builtin_amdgcn_ds_read_tr16_b64_v4i16((LAS s16x4*)p); }
DI bf16x8 cat8(s16x4 a, s16x4 b) { return __builtin_shufflevector(a, b, 0, 1, 2, 3, 4, 5, 6, 7); }
DI bf16x8 lds_b128(LAS const unsigned char* p) { return *(LAS const bf16x8*)p; }
DI LAS unsigned char* olds(LAS unsigned char* l) { unsigned z = 0; asm volatile("" : "+v"(z)); return l + z; }
DI int otid() { int t = threadIdx.x; asm volatile("" : "+v"(t)); return t; }
DI float xor32_sum(float v) { const unsigned u = __float_as_uint(v); auto r = __builtin_amdgcn_permlane32_swap(u, u, false, false); return __uint_as_float(r[0]) + __uint_as_float(r[1]); }
DI f32x16 zero16() { f32x16 z; for (int i = 0; i < 16; ++i) z[i] = 0.f; return z; }

struct Params {
    const float *x, *norm1_w, *w_in, *conv_w, *a_log, *dt_bias, *dn_norm_w, *cmp_pe_k, *cmp_w1_k, *cmp_w2_k, *cmp_pe_v, *cmp_w1_v, *cmp_w2_v,
        *w_up_nsa, *w_up_dn, *w_o, *norm2_w, *w_ffn_gate, *w_ffn_up, *w_ffn_down, *norm_f_w;
    float* out;
    bf16_t *Wt_in, *Wt_gu, *Wt_dn, *Wt_o, *Wt_upn, *Wt_upd, *W1t_k, *W1t_v, *W2t_k, *W2t_v;
    bf16_t *h, *qbuf, *kvbuf, *dnqkv, *dnz, *mg, *onsa, *odn, *mixed, *act, *kc, *vc;
    float *small, *rcos, *rsin, *onsa_f32, *dn_gc, *rowss;
    bf16_t *dn_q, *dn_k, *dn_u, *dn_w, *dn_at;
    unsigned* ctr; unsigned* bar;
};

namespace pg8 {
constexpr int BM = 256, BK = 64, HALF = 128, HTB = HALF * BK * 2, STAGE_BYTES = 8 * HTB, NXCD = 8, WGM = 8;
DI int lds_byte(int r, int c) { const int st = (r >> 4) * 2 + (c >> 5), rr = r & 15, cc = c & 31, ob = rr * 64 + cc * 2; return st * 1024 + (ob ^ (((ob >> 9) & 1) << 5)); }
DI void stage_rc(int b, int& R, int& C) { const int st = b / 1024, sb = b % 1024, swz = sb ^ (((sb >> 9) & 1) << 5); R = (st >> 1) * 16 + swz / 64; C = (st & 1) * 32 + (swz % 64) / 2; }
DI int perm32(int rho) { const int n = rho >> 4, i = rho & 15; return 8 * (i >> 2) + 4 * n + (i & 3); }
struct Unit { int pm, pn; };
struct Gemm { const bf16_t* A; const bf16_t* Bt; int M, N, K; };
struct StaticOrder {
    int nM, nN, nwg, G, c;
    DI void init(int M, int N, int G_, int c_) { nM = M / BM; nN = N / BM; nwg = nM * nN; G = G_; c = c_; }
    DI bool next(int i, Unit& u) const {
        const long L = (long)i * G + c; if (L >= nwg) return false;
        int wgid = (int)L; { const int q = nwg / NXCD, r = nwg % NXCD, xcd = wgid % NXCD, off = wgid / NXCD; wgid = (xcd < r ? xcd * (q + 1) : r * (q + 1) + (xcd - r) * q) + off; }
        const int nig = WGM * nN, gid = wgid / nig, fm = gid * WGM, gsz = (nM - fm) < WGM ? (nM - fm) : WGM;
        u.pm = fm + ((wgid % nig) % gsz); u.pn = (wgid % nig) / gsz; return true;
    }
};

template <class Epi>
DI void gemm_phase(LAS unsigned char* lds, const Gemm g, const StaticOrder& S, const Epi& E) {
    const int tid = otid(), wid = __builtin_amdgcn_readfirstlane(tid >> 6), lane = tid & 63, wr = wid >> 2, wc = wid & 3, fr = lane & 15, fq = lane >> 4;
    const int K = g.K, nt = K / BK;
    unsigned voffA[2], voffB[2];
#pragma unroll
    for (int i = 0; i < 2; ++i) { int R, C; stage_rc(tid * 16 + i * 8192, R, C); const int Rb = Epi::PERM ? ((R & ~31) + perm32(R & 31)) : R;
        voffA[i] = (unsigned)(R * K + C) * 2u; voffB[i] = (unsigned)(Rb * K + C) * 2u; }
    const size_t kstep = (size_t)(BK * 2);
    const size_t hstep = (size_t)HALF * K * 2;
    const size_t tstep = 2 * hstep;
    const unsigned ldsw = (unsigned)wid * 1024u;
    const int aoff = lds_byte(wr * 64 + fr, fq * 8), boff = lds_byte(wc * 32 + fr, fq * 8);
#define PG8_SA(b, h) (((b) * 2 + (h)) * HTB)
#define PG8_SB(b, h) ((4 + (b) * 2 + (h)) * HTB)
#define PG8_STAGE(bufoff, gbase, voff) do { _Pragma("unroll") for (int _i = 0; _i < 2; ++_i) \
        __builtin_amdgcn_global_load_lds((const unsigned*)((const char*)(gbase) + (voff)[_i]), (LAS unsigned*)(lds + (bufoff) + ldsw + _i * 8192), 16, 0, 0); } while (0)
#define PG8_LDA(dst, b, h) do { _Pragma("unroll") for (int m = 0; m < 4; ++m) _Pragma("unroll") for (int k = 0; k < 2; ++k) dst[m][k] = *(const LAS bf16x8*)(lds + PG8_SA(b, h) + aoff + m * 2048 + k * 1024); } while (0)
#define PG8_LDB(dst, b, h) do { _Pragma("unroll") for (int n = 0; n < 2; ++n) _Pragma("unroll") for (int k = 0; k < 2; ++k) dst[n][k] = *(const LAS bf16x8*)(lds + PG8_SB(b, h) + boff + n * 2048 + k * 1024); } while (0)
#define PG8_MMA(ai, bj, At, Bt) do { __builtin_amdgcn_s_setprio(1); _Pragma("unroll") for (int m = 0; m < 4; ++m) _Pragma("unroll") for (int n = 0; n < 2; ++n) _Pragma("unroll") for (int k = 0; k < 2; ++k) \
        acc[ai][bj][m][n] = __builtin_amdgcn_mfma_f32_16x16x32_bf16(Bt[n][k], At[m][k], acc[ai][bj][m][n], 0, 0, 0); __builtin_amdgcn_s_setprio(0); } while (0)
#define PG8_WAIT_V(n) asm volatile("s_waitcnt vmcnt(" #n ")" ::: "memory")
#define PG8_WAIT_L(n) asm volatile("s_waitcnt lgkmcnt(" #n ")" ::: "memory")
#define PG8_BAR __builtin_amdgcn_s_barrier()
#define PG8_SCHED __builtin_amdgcn_sched_barrier(0)
    Unit cur, nxt; int ui = 0;
    if (!S.next(0, cur)) return;
    f32x4 acc[2][2][4][2];
#pragma unroll
    for (int a = 0; a < 2; ++a)
#pragma unroll
        for (int b = 0; b < 2; ++b)
#pragma unroll
            for (int m = 0; m < 4; ++m)
#pragma unroll
                for (int n = 0; n < 2; ++n) acc[a][b][m][n] = (f32x4){0.f, 0.f, 0.f, 0.f};
    bf16x8 At[4][2], B0[2][2], B1[2][2];
    const char* cA = (const char*)g.A + (size_t)cur.pm * tstep; const char* cB = (const char*)g.Bt + (size_t)cur.pn * tstep;
    PG8_STAGE(PG8_SB(0, 0), cB, voffB); PG8_STAGE(PG8_SA(0, 0), cA, voffA); PG8_STAGE(PG8_SB(0, 1), cB + hstep, voffB); PG8_STAGE(PG8_SA(0, 1), cA + hstep, voffA);
    if (wr == 1) PG8_BAR;
    PG8_WAIT_V(4); PG8_BAR;
    PG8_STAGE(PG8_SB(1, 0), cB + kstep, voffB); PG8_STAGE(PG8_SA(1, 0), cA + kstep, voffA); PG8_STAGE(PG8_SB(1, 1), cB + hstep + kstep, voffB);
    PG8_WAIT_V(6); PG8_BAR;
    for (;;) {
        const bool has_next = S.next(ui + 1, nxt);
        const char* nA = has_next ? (const char*)g.A + (size_t)nxt.pm * tstep : cA; const char* nB = has_next ? (const char*)g.Bt + (size_t)nxt.pn * tstep : cB;
        for (int t = 0; t < nt; t += 2) {
            const bool last = (t == nt - 2);
            const char* a1 = cA + (size_t)(t + 1) * kstep;
            const char* a2 = last ? nA : cA + (size_t)(t + 2) * kstep; const char* b2 = last ? nB : cB + (size_t)(t + 2) * kstep;
            const char* a3 = a2 + kstep; const char* b3 = b2 + kstep;
            PG8_LDB(B0, 0, 0); PG8_SCHED; PG8_LDA(At, 0, 0); PG8_STAGE(PG8_SA(1, 1), a1 + hstep, voffA);
            PG8_WAIT_L(8); PG8_BAR; PG8_WAIT_L(0); PG8_MMA(0, 0, At, B0); PG8_BAR; PG8_SCHED;
            PG8_LDB(B1, 0, 1); PG8_STAGE(PG8_SB(0, 0), b2, voffB);
            PG8_BAR; PG8_WAIT_L(0); PG8_MMA(0, 1, At, B1); PG8_BAR;
            PG8_LDA(At, 0, 1); PG8_STAGE(PG8_SA(0, 0), a2, voffA);
            PG8_BAR; PG8_WAIT_L(0); PG8_MMA(1, 0, At, B0); PG8_BAR; PG8_SCHED;
            PG8_STAGE(PG8_SB(0, 1), b2 + hstep, voffB);
            PG8_WAIT_V(6); PG8_BAR; PG8_MMA(1, 1, At, B1); PG8_BAR;
            PG8_LDB(B0, 1, 0); PG8_SCHED; PG8_LDA(At, 1, 0); PG8_STAGE(PG8_SA(0, 1), a2 + hstep, voffA);
            PG8_WAIT_L(8); PG8_BAR; PG8_WAIT_L(0); PG8_MMA(0, 0, At, B0); PG8_BAR; PG8_SCHED;
            PG8_LDB(B1, 1, 1); PG8_STAGE(PG8_SB(1, 0), b3, voffB);
            PG8_BAR; PG8_WAIT_L(0); PG8_MMA(0, 1, At, B1); PG8_BAR;
            PG8_LDA(At, 1, 1); PG8_STAGE(PG8_SA(1, 0), a3, voffA);
            PG8_BAR; PG8_WAIT_L(0); PG8_MMA(1, 0, At, B0); PG8_BAR; PG8_SCHED;
            PG8_STAGE(PG8_SB(1, 1), b3 + hstep, voffB);
            PG8_WAIT_V(6); PG8_BAR; PG8_MMA(1, 1, At, B1); PG8_BAR;
        }
        E(acc, cur, wr, wc, fr, fq);
        if (!has_next) break;
#pragma unroll
        for (int a = 0; a < 2; ++a)
#pragma unroll
            for (int b = 0; b < 2; ++b)
#pragma unroll
                for (int m = 0; m < 4; ++m)
#pragma unroll
                    for (int n = 0; n < 2; ++n) acc[a][b][m][n] = (f32x4){0.f, 0.f, 0.f, 0.f};
        cur = nxt; cA = nA; cB = nB; ++ui;
    }
    PG8_WAIT_V(0);
    if (wr == 0) PG8_BAR;
    PG8_BAR;
#undef PG8_SA
#undef PG8_SB
#undef PG8_STAGE
#undef PG8_LDA
#undef PG8_LDB
#undef PG8_MMA
#undef PG8_WAIT_V
#undef PG8_WAIT_L
#undef PG8_BAR
#undef PG8_SCHED
}
}
using pg8::Unit;

typedef f32x4 AccT[2][2][4][2];

struct EpiInProj {
    static constexpr bool PERM = true;
    bf16_t *qbuf, *kvbuf, *dnqkv, *dnz, *mg; float* small; const float *rcos, *rsin;
    DI void operator()(const AccT& acc, const Unit& u, int wr, int wc, int fr, int fq) const {
        const int pn = u.pn; const int row0 = u.pm * 256 + wr * 64 + fr; const int cl = wc * 32 + 8 * fq;
        if (pn == 42) {
            if (wc < 2) {
#pragma unroll
                for (int ai = 0; ai < 2; ++ai)
#pragma unroll
                    for (int m = 0; m < 4; ++m) { float* rp = small + (size_t)(row0 + ai * 128 + m * 16) * 64 + cl;
                        *(f32x4*)(rp) = acc[ai][0][m][0]; *(f32x4*)(rp + 4) = acc[ai][0][m][1]; }
            }
            return;
        }
        bf16_t* dst; int ld, cbase; bool rope = false;
        if (pn < 4) { dst = qbuf; ld = 1024; cbase = pn * 256; rope = true; }
        else if (pn < 10) { dst = kvbuf; ld = 1536; cbase = (pn - 4) * 256; rope = ((pn - 4) & 1) == 0; }
        else if (pn < 22) { dst = dnqkv; ld = 3072; cbase = (pn - 10) * 256; }
        else if (pn < 26) { dst = dnz; ld = 1024; cbase = (pn - 22) * 256; }
        else { dst = mg; ld = 4096; cbase = (pn - 26) * 256; }
        if (rope) {
            const int i4 = 4 * (4 * wc + fq);
            f32x4 invr;
#pragma unroll
            for (int e = 0; e < 4; ++e) invr[e] = fexp2(-(float)(2 * (i4 + e)) * (13.287712379549449f / 128.0f)) * 0.15915494309189535f;
#pragma unroll
            for (int ai = 0; ai < 2; ++ai)
#pragma unroll
                for (int m = 0; m < 4; ++m) {
                    const int row = row0 + ai * 128 + m * 16; const int t = row & (SEQ - 1);
                    f32x4 c, s;
#pragma unroll
                    for (int e = 0; e < 4; ++e) { float rev = (float)t * invr[e]; rev = rev - floorf(rev); c[e] = __builtin_amdgcn_cosf(rev); s[e] = __builtin_amdgcn_sinf(rev); }
#pragma unroll
                    for (int bj = 0; bj < 2; ++bj) {
                        const f32x4 x1 = acc[ai][bj][m][0], x2 = acc[ai][bj][m][1];
                        const f32x4 o1 = x1 * c - x2 * s, o2 = x2 * c + x1 * s;
                        bf16_t* rp = dst + (size_t)row * ld + cbase + bj * 128 + i4;
                        u32x2 w1 = {pk2(o1[0], o1[1]), pk2(o1[2], o1[3])}, w2 = {pk2(o2[0], o2[1]), pk2(o2[2], o2[3])};
                        *(u32x2*)rp = w1; *(u32x2*)(rp + 64) = w2;
                    }
                }
        } else {
#pragma unroll
            for (int ai = 0; ai < 2; ++ai)
#pragma unroll
                for (int m = 0; m < 4; ++m) {
                    bf16_t* rp = dst + (size_t)(row0 + ai * 128 + m * 16) * ld + cbase + cl;
#pragma unroll
                    for (int bj = 0; bj < 2; ++bj) { const f32x4 v0 = acc[ai][bj][m][0], v1 = acc[ai][bj][m][1];
                        u32x4 w = {pk2(v0[0], v0[1]), pk2(v0[2], v0[3]), pk2(v1[0], v1[1]), pk2(v1[2], v1[3])};
                        *(u32x4*)(rp + bj * 128) = w; }
                }
        }
    }
};

template <int PASS> struct EpiUp {
    static constexpr bool PERM = true;
    bf16_t* mixed; const bf16_t* mg; int gofs;
    DI void operator()(const AccT& acc, const Unit& u, int wr, int wc, int fr, int fq) const {
        const int row0 = u.pm * 256 + wr * 64 + fr; const int col0 = u.pn * 256 + wc * 32 + 8 * fq;
#pragma unroll
        for (int ai = 0; ai < 2; ++ai)
#pragma unroll
            for (int mh = 0; mh < 2; ++mh) {
                u32x4 gvv[2][2], pvv[2][2];
#pragma unroll
                for (int mm = 0; mm < 2; ++mm) { const size_t row = (size_t)(row0 + ai * 128 + (2 * mh + mm) * 16);
#pragma unroll
                    for (int bj = 0; bj < 2; ++bj) { const int col = col0 + bj * 128;
                        gvv[mm][bj] = *(const u32x4*)(mg + row * 4096 + gofs + col);
                        if (PASS == 1) pvv[mm][bj] = *(const u32x4*)(mixed + row * 2048 + col); } }
#pragma unroll
                for (int mm = 0; mm < 2; ++mm) { const size_t row = (size_t)(row0 + ai * 128 + (2 * mh + mm) * 16);
#pragma unroll
                    for (int bj = 0; bj < 2; ++bj) {
                        const int col = col0 + bj * 128; const u32x4 gv = gvv[mm][bj];
                        bf16_t* op = mixed + row * 2048 + col;
                        const f32x4 v0 = acc[ai][bj][2 * mh + mm][0], v1 = acc[ai][bj][2 * mh + mm][1];
                        float r[8];
                        r[0] = sigmoidf_(bflo(gv[0])) * v0[0]; r[1] = sigmoidf_(bfhi(gv[0])) * v0[1]; r[2] = sigmoidf_(bflo(gv[1])) * v0[2]; r[3] = sigmoidf_(bfhi(gv[1])) * v0[3];
                        r[4] = sigmoidf_(bflo(gv[2])) * v1[0]; r[5] = sigmoidf_(bfhi(gv[2])) * v1[1]; r[6] = sigmoidf_(bflo(gv[3])) * v1[2]; r[7] = sigmoidf_(bfhi(gv[3])) * v1[3];
                        if (PASS == 1) { const u32x4 pv = pvv[mm][bj];
                            r[0] += bflo(pv[0]); r[1] += bfhi(pv[0]); r[2] += bflo(pv[1]); r[3] += bfhi(pv[1]); r[4] += bflo(pv[2]); r[5] += bfhi(pv[2]); r[6] += bflo(pv[3]); r[7] += bfhi(pv[3]); }
                        u32x4 w = {pk2(r[0], r[1]), pk2(r[2], r[3]), pk2(r[4], r[5]), pk2(r[6], r[7])};
                        *(u32x4*)op = w;
                    } }
            }
    }
};

template <int ACCUM> struct EpiResF32 {
    static constexpr bool PERM = false;
    float* out; const float* resid;
    DI void operator()(const AccT& acc, const Unit& u, int wr, int wc, int fr, int fq) const {
        const int row0 = u.pm * 256 + wr * 64 + fr, col0 = u.pn * 256 + wc * 32 + 4 * fq;
        const float* src = ACCUM ? (const float*)out : resid;
#pragma unroll
        for (int ai = 0; ai < 2; ++ai)
#pragma unroll
            for (int mh = 0; mh < 2; ++mh) {
                f32x4 base[2][2][2];
#pragma unroll
                for (int mm = 0; mm < 2; ++mm) { const size_t ro = (size_t)(row0 + ai * 128 + (2 * mh + mm) * 16) * DM + col0;
#pragma unroll
                    for (int bj = 0; bj < 2; ++bj)
#pragma unroll
                        for (int n = 0; n < 2; ++n) base[mm][bj][n] = *(const f32x4*)(src + ro + bj * 128 + n * 16); }
#pragma unroll
                for (int mm = 0; mm < 2; ++mm) { const size_t ro = (size_t)(row0 + ai * 128 + (2 * mh + mm) * 16) * DM + col0;
#pragma unroll
                    for (int bj = 0; bj < 2; ++bj)
#pragma unroll
                        for (int n = 0; n < 2; ++n) *(f32x4*)(out + ro + bj * 128 + n * 16) = base[mm][bj][n] + acc[ai][bj][2 * mh + mm][n]; }
            }
    }
};

struct EpiWo {
    static constexpr bool PERM = false;
    float* out; const float* resid; bf16_t* xb; float* rowss;
    DI void operator()(const AccT& acc, const Unit& u, int wr, int wc, int fr, int fq) const {
        const int row0 = u.pm * 256 + wr * 64 + fr, col0 = u.pn * 256 + wc * 32 + 4 * fq;
#pragma unroll
        for (int ai = 0; ai < 2; ++ai)
#pragma unroll
            for (int mh = 0; mh < 2; ++mh) {
                f32x4 base[2][2][2];
#pragma unroll
                for (int mm = 0; mm < 2; ++mm) { const size_t ro = (size_t)(row0 + ai * 128 + (2 * mh + mm) * 16) * DM + col0;
#pragma unroll
                    for (int bj = 0; bj < 2; ++bj)
#pragma unroll
                        for (int n = 0; n < 2; ++n) base[mm][bj][n] = *(const f32x4*)(resid + ro + bj * 128 + n * 16); }
#pragma unroll
                for (int mm = 0; mm < 2; ++mm) { const int row = row0 + ai * 128 + (2 * mh + mm) * 16; const size_t ro = (size_t)row * DM + col0;
                    float ss = 0.f;
#pragma unroll
                    for (int bj = 0; bj < 2; ++bj)
#pragma unroll
                        for (int n = 0; n < 2; ++n) { const f32x4 v = base[mm][bj][n] + acc[ai][bj][2 * mh + mm][n];
                            *(f32x4*)(out + ro + bj * 128 + n * 16) = v;
                            u32x2 w = {pk2(v[0], v[1]), pk2(v[2], v[3])}; *(u32x2*)(xb + ro + bj * 128 + n * 16) = w;
                            ss += v[0] * v[0] + v[1] * v[1] + v[2] * v[2] + v[3] * v[3]; }
                    ss += __shfl_xor(ss, 16); ss += __shfl_xor(ss, 32);
                    if (fq == 0) atomicAdd(rowss + row, ss);
                }
            }
    }
};

struct EpiGU {
    static constexpr bool PERM = true;
    bf16_t* act; const float* rowss;
    DI void operator()(const AccT& acc, const Unit& u, int wr, int wc, int fr, int fq) const {
        const int row0 = u.pm * 256 + wr * 64 + fr; const int col0 = (u.pn * 256 + wc * 32 + 8 * fq) >> 1;
        float rs[2][4];
#pragma unroll
        for (int ai = 0; ai < 2; ++ai)
#pragma unroll
            for (int m = 0; m < 4; ++m) rs[ai][m] = rowss[row0 + ai * 128 + m * 16];
#pragma unroll
        for (int ai = 0; ai < 2; ++ai)
#pragma unroll
            for (int m = 0; m < 4; ++m) rs[ai][m] = rsqrtf(rs[ai][m] * (1.0f / DM) + EPS);
#pragma unroll
        for (int ai = 0; ai < 2; ++ai)
#pragma unroll
            for (int m = 0; m < 4; ++m) { bf16_t* rp = act + (size_t)(row0 + ai * 128 + m * 16) * DFF + col0; const float r = rs[ai][m];
#pragma unroll
                for (int bj = 0; bj < 2; ++bj) { const f32x4 gt = acc[ai][bj][m][0] * r, up = acc[ai][bj][m][1] * r;
                    u32x2 w = {pk2(siluf_(gt[0]) * up[0], siluf_(gt[1]) * up[1]), pk2(siluf_(gt[2]) * up[2], siluf_(gt[3]) * up[3])};
                    *(u32x2*)(rp + bj * 64) = w; } }
    }
};

DI float wave_sum(float v) {
#pragma unroll
    for (int o = 32; o >= 1; o >>= 1) v += __shfl_xor(v, o);
    return v;
}

__device__ void rmsnorm_rows(const float* __restrict__ x, const float* __restrict__ w, bf16_t* outb, float* outf, int nrows) {
    const int tid_ = otid(); const int lane = tid_ & 63; const int gw = blockIdx.x * 8 + (tid_ >> 6), nw = gridDim.x * 8;
    for (int row = gw; row < nrows; row += nw) {
        const f32x4* xr = (const f32x4*)(x + (size_t)row * DM);
        f32x4 v[8]; float ss = 0.f;
#pragma unroll
        for (int i = 0; i < 8; ++i) { v[i] = xr[lane + 64 * i]; ss += v[i][0] * v[i][0] + v[i][1] * v[i][1] + v[i][2] * v[i][2] + v[i][3] * v[i][3]; }
        ss = wave_sum(ss);
        const float r = rsqrtf(ss * (1.0f / DM) + EPS);
#pragma unroll
        for (int i = 0; i < 8; ++i) { const f32x4 wv = ((const f32x4*)w)[lane + 64 * i]; const f32x4 o = v[i] * r * wv;
            if (outb) { u32x2 pw = {pk2(o[0], o[1]), pk2(o[2], o[3])}; *(u32x2*)(outb + (size_t)row * DM + 4 * (lane + 64 * i)) = pw; }
            else { *(f32x4*)(outf + (size_t)row * DM + 4 * (lane + 64 * i)) = o; } }
    }
}

DI int rope_perm(int r) { const int i = r >> 3, j = r & 7; return j < 4 ? 4 * i + j : 64 + 4 * i + (j - 4); }
DI int src_in(int p) {
    if (p < 1024) return (p & ~127) + rope_perm(p & 127);
    if (p < 2560) { const int pp = p - 1024; const int grp = pp >> 8; if (!(grp & 1)) return 1024 + (pp & ~127) + rope_perm(pp & 127); return 1024 + pp; }
    if (p < 5632) return 2584 + (p - 2560);
    if (p < 6656) return 5656 + (p - 5632);
    if (p < 10752) return 6696 + (p - 6656);
    const int s = p - 10752;
    if (s < 24) return 2560 + s;
    if (s < 32) return 6680 + (s - 24);
    if (s < 40) return 6688 + (s - 32);
    return -1;
}

template <int MODE, int PW>
__device__ void transpose_tiles(const float* __restrict__ W, const float* __restrict__ W2, int K, int N, bf16_t* Wt, int Np, LAS float* tile, int t0, int tstep, int tend, const float* __restrict__ kscale = nullptr) {
    const int tid = otid(); const int nkt = K / 64;
    constexpr int PQ = PW / 4, KR = 512 / PQ;
    for (int tt = t0; tt < tend; tt += tstep) {
        const int pt = tt / nkt, kt = tt % nkt; const int p0 = pt * PW, k0 = kt * 64;
        { const int pl = (tid % PQ) * 4, kr = tid / PQ; const int p = p0 + pl; const float* src = W; int sc;
          if (MODE == 0) sc = p; else if (MODE == 1) sc = src_in(p); else { const int g8 = p >> 3, j = p & 7; sc = 4 * g8 + (j & 3); if (j >= 4) src = W2; }
          const float* sp = src + (size_t)(k0 + kr) * N + (sc >= 0 ? sc : 0);
          f32x4 v[64 / KR];
#pragma unroll
          for (int i = 0; i < 64 / KR; ++i) v[i] = *(const f32x4*)(sp + (size_t)(i * KR) * N);
#pragma unroll
          for (int i = 0; i < 64 / KR; ++i) { LAS float* tp = tile + (kr + i * KR) * (PW + 1) + pl; const bool ok = sc >= 0;
              const float ks = kscale ? kscale[k0 + kr + i * KR] : 1.f;
              tp[0] = ok ? v[i][0] * ks : 0.f; tp[1] = ok ? v[i][1] * ks : 0.f; tp[2] = ok ? v[i][2] * ks : 0.f; tp[3] = ok ? v[i][3] * ks : 0.f; } }
        __syncthreads();
        { const int kq = tid & 7, pr = tid >> 3;
#pragma unroll
          for (int ps = 0; ps < PW / 64; ++ps) { float v[8]; const int prr = pr + 64 * ps;
#pragma unroll
              for (int i = 0; i < 8; ++i) v[i] = tile[(8 * kq + i) * (PW + 1) + prr];
              u32x4 w = {pk2(v[0], v[1]), pk2(v[2], v[3]), pk2(v[4], v[5]), pk2(v[6], v[7])};
              *(u32x4*)(Wt + (size_t)(p0 + prr) * K + k0 + 8 * kq) = w; } }
        __syncthreads();
    }
}
template <int MODE, int PW>
__device__ void transpose_w(const float* __restrict__ W, const float* __restrict__ W2, int K, int N, bf16_t* Wt, int Np, LAS float* tile, int& tcount) {
    const int ntile = (K / 64) * (Np / PW);
    transpose_tiles<MODE, PW>(W, W2, K, N, Wt, Np, tile, ((int)blockIdx.x - tcount % (int)gridDim.x + (int)gridDim.x) % (int)gridDim.x, (int)gridDim.x, ntile);
    tcount += ntile;
}

__device__ void phase_prep(const Params& p, LAS unsigned char* lds) {
    if (blockIdx.x == 0 && threadIdx.x == 0) { p.ctr[0] = 0u; p.ctr[1] = 0u; }
    for (int i = blockIdx.x * 512 + threadIdx.x; i < T_TOK; i += gridDim.x * 512) p.rowss[i] = 0.f;
    rmsnorm_rows(p.x, p.norm1_w, p.h, nullptr, T_TOK);
    LAS float* tile = (LAS float*)lds; int tc = 0;
    transpose_w<1, 256>(p.w_in, nullptr, DM, 10792, p.Wt_in, NIN_P, tile, tc);
    transpose_w<0, 256>(p.w_o, nullptr, DM, DM, p.Wt_o, DM, tile, tc);
    transpose_w<0, 256>(p.w_up_nsa, nullptr, 1024, DM, p.Wt_upn, DM, tile, tc);
    transpose_w<0, 256>(p.w_up_dn, nullptr, 1024, DM, p.Wt_upd, DM, tile, tc);
    transpose_w<0, 128>(p.cmp_w1_k, nullptr, 4096, 128, p.W1t_k, 128, tile, tc);
    transpose_w<0, 128>(p.cmp_w1_v, nullptr, 4096, 128, p.W1t_v, 128, tile, tc);
    transpose_w<0, 128>(p.cmp_w2_k, nullptr, 128, 128, p.W2t_k, 128, tile, tc);
    transpose_w<0, 128>(p.cmp_w2_v, nullptr, 128, 128, p.W2t_v, 128, tile, tc);
}

DI float gelu_tanh(float x) { const float u = 0.7978845608028654f * (x + 0.044715f * x * x * x); const float e = fexp(2.f * u); return 0.5f * x * (2.f - 2.f * frcp(e + 1.f)); }

__device__ void phase_compress(const Params& p, LAS unsigned char* lds) {
    const int tid = otid(), wid = tid >> 6, lane = tid & 63, l32 = lane & 31, h = lane >> 5;
    const int kq = wid & 3, nh = wid >> 2;
    LAS float* red = (LAS float*)lds;
    LAS unsigned char* Hs = lds + 4 * 32 * 132 * 4;
    for (int item = blockIdx.x; item < 128; item += gridDim.x) {
        const int mt = item & 3, hk = (item >> 2) & 1, b = (item >> 3) & 7, kv = item >> 6;
        const bf16_t* W1t = kv ? p.W1t_v : p.W1t_k; const bf16_t* W2t = kv ? p.W2t_v : p.W2t_k; const float* pe = kv ? p.cmp_pe_v : p.cmp_pe_k;
        bf16_t* outp = (kv ? p.vc : p.kc) + (size_t)((b * 2 + hk) * 128) * 128;
        const int c = 32 * mt + l32;
        const bf16_t* abase = p.kvbuf + (size_t)(b * SEQ) * 1536 + kv * 256 + hk * 128 + 32 * kq + 8 * h;
        f32x16 acc[2]; acc[0] = zero16(); acc[1] = zero16();
#pragma unroll 4
        for (int li = 0; li < 32; ++li) {
            int tok = 16 * c + li; tok = tok > SEQ - 1 ? SEQ - 1 : tok;
#pragma unroll
            for (int s2 = 0; s2 < 2; ++s2) {
                const u32x4 av = *(const u32x4*)(abase + (size_t)tok * 1536 + 16 * s2);
                const f32x4 pe0 = *(const f32x4*)(pe + li * 128 + 32 * kq + 16 * s2 + 8 * h), pe1 = *(const f32x4*)(pe + li * 128 + 32 * kq + 16 * s2 + 8 * h + 4);
                u32x4 aw = {pk2(bflo(av[0]) + pe0[0], bfhi(av[0]) + pe0[1]), pk2(bflo(av[1]) + pe0[2], bfhi(av[1]) + pe0[3]),
                            pk2(bflo(av[2]) + pe1[0], bfhi(av[2]) + pe1[1]), pk2(bflo(av[3]) + pe1[2], bfhi(av[3]) + pe1[3])};
                const bf16x8 af = __builtin_bit_cast(bf16x8, aw);
#pragma unroll
                for (int n2 = 0; n2 < 2; ++n2) {
                    const bf16x8 bfr = *(const bf16x8*)(W1t + (size_t)(64 * nh + 32 * n2 + l32) * 4096 + li * 128 + 32 * kq + 16 * s2 + 8 * h);
                    acc[n2] = mfma32(af, bfr, acc[n2]);
                }
            }
        }
#pragma unroll
        for (int n2 = 0; n2 < 2; ++n2)
#pragma unroll
            for (int r = 0; r < 16; ++r) red[(kq * 32 + 8 * (r >> 2) + 4 * h + (r & 3)) * 132 + 64 * nh + 32 * n2 + l32] = acc[n2][r];
        __syncthreads();
        { const int row = tid >> 4, c8 = (tid & 15) * 8; float v[8];
#pragma unroll
          for (int i = 0; i < 8; ++i) { const int o = row * 132 + c8 + i; v[i] = gelu_tanh(red[o] + red[32 * 132 + o] + red[2 * 32 * 132 + o] + red[3 * 32 * 132 + o]); }
          u32x4 w = {pk2(v[0], v[1]), pk2(v[2], v[3]), pk2(v[4], v[5]), pk2(v[6], v[7])};
          *(LAS u32x4*)(Hs + row * 272 + c8 * 2) = w; }
        __syncthreads();
        if (wid < 4) {
            f32x16 o = zero16();
#pragma unroll
            for (int ks = 0; ks < 8; ++ks) {
                const bf16x8 af = lds_b128(Hs + l32 * 272 + (16 * ks + 8 * h) * 2);
                const bf16x8 bfr = *(const bf16x8*)(W2t + (size_t)(32 * wid + l32) * 128 + 16 * ks + 8 * h);
                o = mfma32(af, bfr, o);
            }
#pragma unroll
            for (int r = 0; r < 16; ++r) outp[(size_t)(32 * mt + 8 * (r >> 2) + 4 * h + (r & 3)) * 128 + 32 * wid + l32] = f2bf(o[r]);
        }
        __syncthreads();
    }
}

constexpr int KS = 272, VS = 320;
constexpr int L_K0 = 0, L_K1 = 17408, L_V0 = 34816, L_V1 = 55296, L_PART = 75776, L_MASK = 109568, L_Q = 131056;
constexpr float SC_LOG2E = 0.08838834764831845f * 1.4426950408889634f;

struct KVRegs { u32x4 k0, k1, v0, v1; };
DI void kv_load(KVRegs& r, const bf16_t* Kg, const bf16_t* Vg, int ld, int j, int tid) {
    const int r0 = tid >> 4, c16 = tid & 15;
    const size_t o0 = (size_t)(64 * j + r0) * ld + 8 * c16, o1 = o0 + (size_t)32 * ld;
    r.k0 = *(const u32x4*)(Kg + o0); r.k1 = *(const u32x4*)(Kg + o1); r.v0 = *(const u32x4*)(Vg + o0); r.v1 = *(const u32x4*)(Vg + o1);
}
DI void kv_store(const KVRegs& r, LAS unsigned char* Kl, LAS unsigned char* Vl, int tid) {
    const int r0 = tid >> 4, c16 = tid & 15;
    *(LAS u32x4*)(Kl + r0 * KS + 16 * c16) = r.k0; *(LAS u32x4*)(Kl + (r0 + 32) * KS + 16 * c16) = r.k1;
    *(LAS u32x4*)(Vl + r0 * VS + 16 * c16) = r.v0; *(LAS u32x4*)(Vl + (r0 + 32) * VS + 16 * c16) = r.v1;
}
DI void qk_block(LAS const unsigned char* Kl, const bf16x8 (&qf)[8], int lane, f32x16& s0, f32x16& s1) {
    const int l32 = lane & 31, h = lane >> 5;
    s0 = zero16(); s1 = zero16();
    LAS const unsigned char* kp = Kl + l32 * KS + 16 * h;
    bf16x8 A[2][4];
    A[0][0] = lds_b128(kp); A[0][1] = lds_b128(kp + 32 * KS); A[0][2] = lds_b128(kp + 32); A[0][3] = lds_b128(kp + 32 * KS + 32);
#pragma unroll
    for (int b = 0; b < 4; ++b) {
        if (b < 3) { A[(b + 1) & 1][0] = lds_b128(kp + 64 * (b + 1)); A[(b + 1) & 1][1] = lds_b128(kp + 32 * KS + 64 * (b + 1));
                     A[(b + 1) & 1][2] = lds_b128(kp + 64 * (b + 1) + 32); A[(b + 1) & 1][3] = lds_b128(kp + 32 * KS + 64 * (b + 1) + 32); }
        s0 = mfma32(A[b & 1][0], qf[2 * b], s0); s1 = mfma32(A[b & 1][1], qf[2 * b], s1);
        s0 = mfma32(A[b & 1][2], qf[2 * b + 1], s0); s1 = mfma32(A[b & 1][3], qf[2 * b + 1], s1);
    }
}
DI bf16x8 pack8(const f32x16& p, int q) {
    u32x4 w = {pk2(p[8 * q], p[8 * q + 1]), pk2(p[8 * q + 2], p[8 * q + 3]), pk2(p[8 * q + 4], p[8 * q + 5]), pk2(p[8 * q + 6], p[8 * q + 7])};
    return __builtin_bit_cast(bf16x8, w);
}
DI void pv_block(LAS const unsigned char* Vl, const bf16x8 (&pb)[4], int lane, f32x16 (&o)[4]) {
    const int h = lane >> 5;
    LAS const unsigned char* vp = Vl + (4 * h + ((lane & 15) >> 2)) * VS + (16 * ((lane >> 4) & 1) + 4 * (lane & 3)) * 2;
    s16x4 V[2][8];
#pragma unroll
    for (int dt = 0; dt < 4; ++dt) { V[0][2 * dt] = tr_read(vp + 64 * dt); V[0][2 * dt + 1] = tr_read(vp + 8 * VS + 64 * dt); }
#pragma unroll
    for (int kq = 0; kq < 4; ++kq) {
        if (kq < 3) {
#pragma unroll
            for (int dt = 0; dt < 4; ++dt) { V[(kq + 1) & 1][2 * dt] = tr_read(vp + (16 * (kq + 1)) * VS + 64 * dt); V[(kq + 1) & 1][2 * dt + 1] = tr_read(vp + (16 * (kq + 1) + 8) * VS + 64 * dt); }
        }
#pragma unroll
        for (int dt = 0; dt < 4; ++dt) o[dt] = mfma32(cat8(V[kq & 1][2 * dt], V[kq & 1][2 * dt + 1]), pb[kq], o[dt]);
    }
}
DI void softmax_block(f32x16& s0, f32x16& s1, int lo, int hi, int h, float& m, float& l, f32x16 (&o)[4], bf16x8 (&pb)[4]) {
    float mx = -1e30f;
    if (__any((lo > 0) || (hi < 63))) {
        const int lo2 = lo - 4 * h, hi2 = hi - 4 * h;
#pragma unroll
        for (int i = 0; i < 16; ++i) { const int k0 = 8 * (i >> 2) + (i & 3);
            s0[i] = (k0 >= lo2 && k0 <= hi2) ? s0[i] : -1e30f; s1[i] = (k0 + 32 >= lo2 && k0 + 32 <= hi2) ? s1[i] : -1e30f; }
    }
#pragma unroll
    for (int i = 0; i < 16; ++i) mx = fmaxf(mx, fmaxf(s0[i], s1[i]));
    mx = fmaxf(mx, __shfl_xor(mx, 32));
    const float mn = fmaxf(m, mx);
    const float alpha = fexp2((m - mn) * SC_LOG2E);
    const float mb = mn * SC_LOG2E;
    m = mn;
    float ps = 0.f;
#pragma unroll
    for (int i = 0; i < 16; ++i) { s0[i] = fexp2(s0[i] * SC_LOG2E - mb); s1[i] = fexp2(s1[i] * SC_LOG2E - mb); ps += s0[i] + s1[i]; }
    l = l * alpha + ps;
    if (__any(alpha != 1.0f)) {
#pragma unroll
        for (int dt = 0; dt < 4; ++dt) o[dt] = o[dt] * alpha;
    }
    pb[0] = pack8(s0, 0); pb[1] = pack8(s0, 1); pb[2] = pack8(s1, 0); pb[3] = pack8(s1, 1);
}

template <int MODE>
DI void branch_out(const f32x16 (&o)[4], float fac, float* of32, bf16_t* obf, int h) {
#pragma unroll
    for (int dt = 0; dt < 4; ++dt)
#pragma unroll
        for (int ig = 0; ig < 4; ++ig) {
            const int d0 = 32 * dt + 8 * ig + 4 * h;
            f32x4 v = {o[dt][4 * ig] * fac, o[dt][4 * ig + 1] * fac, o[dt][4 * ig + 2] * fac, o[dt][4 * ig + 3] * fac};
            if (MODE >= 1) v += *(const f32x4*)(of32 + d0);
            if (MODE <= 1) *(f32x4*)(of32 + d0) = v;
            if (MODE == 2) { u32x2 w = {pk2(v[0], v[1]), pk2(v[2], v[3])}; *(u32x2*)(obf + d0) = w; }
        }
}

template <int MODE>
DI void attn_stream(const bf16_t* Kg, const bf16_t* Vg, int jlo, int jhi, unsigned blockmask, unsigned mymask, int qb, int tl,
                    const bf16x8 (&qf)[8], f32x16 (&o)[4], float& m, float& l, LAS unsigned char* lds, int tid, int lane) {
    const int h = lane >> 5;
    int j = jlo;
    if (MODE == 1) { while (j <= jhi && !((blockmask >> j) & 1u)) ++j; }
    KVRegs kr;
    kv_load(kr, Kg, Vg, 1536, j, tid);
    kv_store(kr, lds + L_K0, lds + L_V0, tid);
    __syncthreads();
    int cur = 0;
    for (;;) {
        int jn = j + 1;
        if (MODE == 1) { while (jn <= jhi && !((blockmask >> jn) & 1u)) ++jn; }
        const bool hn = jn <= jhi;
        if (hn) kv_load(kr, Kg, Vg, 1536, jn, tid);
        LAS unsigned char* Kl = lds + (cur ? L_K1 : L_K0); LAS unsigned char* Vl = lds + (cur ? L_V1 : L_V0);
        f32x16 s0, s1; qk_block(Kl, qf, lane, s0, s1);
        int lo = 0, hi = 63;
        if (MODE == 1) { if (j == qb) hi = tl; if (!((mymask >> j) & 1u)) hi = -1; }
        else { if (j == qb - 8) lo = tl + 1; if (j == qb) hi = tl; }
        bf16x8 pb[4];
        softmax_block(s0, s1, lo, hi, h, m, l, o, pb);
        pv_block(Vl, pb, lane, o);
        if (!hn) break;
        kv_store(kr, lds + (cur ? L_K0 : L_K1), lds + (cur ? L_V0 : L_V1), tid);
        __syncthreads();
        cur ^= 1; j = jn;
    }
    __syncthreads();
}

__device__ void nsa_item(const Params& p, int b, int hk, int qb, LAS unsigned char* lds) {
    const int tid = otid(), wid = tid >> 6, lane = tid & 63, l32 = lane & 31, h = lane >> 5;
    const int g = wid >> 1, tl = (wid & 1) * 32 + l32, t = qb * 64 + tl; const size_t row = (size_t)b * SEQ + t; const int head = hk * 4 + g;
    bf16x8 qf[8];
    { const bf16_t* qp = p.qbuf + row * 1024 + head * 128 + 8 * h;
#pragma unroll
      for (int ks = 0; ks < 8; ++ks) qf[ks] = *(const bf16x8*)(qp + 16 * ks); }
    const float* glp = p.small + row * 64 + head * 3;
    const float gate0 = sigmoidf_(glp[0]), gate1 = sigmoidf_(glp[1]), gate2 = sigmoidf_(glp[2]);
    float* of32 = p.onsa_f32 + row * 1024 + head * 128; bf16_t* obf = p.onsa + row * 1024 + head * 128;
    f32x16 o[4];
    const int ncb = (qb >= 16) ? 2 : 1;
    {
        const bf16_t* kcg = p.kc + (size_t)((b * 2 + hk) * 128) * 128; const bf16_t* vcg = p.vc + (size_t)((b * 2 + hk) * 128) * 128;
        KVRegs kr;
        kv_load(kr, kcg, vcg, 128, 0, tid); kv_store(kr, lds + L_K0, lds + L_V0, tid);
        if (ncb == 2) { kv_load(kr, kcg, vcg, 128, 1, tid); kv_store(kr, lds + L_K1, lds + L_V1, tid); }
        __syncthreads();
        const int cmax = (t >= 31) ? min(126, (t - 31) >> 4) : -1;
        f32x16 s[4];
        qk_block(lds + L_K0, qf, lane, s[0], s[1]);
        if (ncb == 2) qk_block(lds + L_K1, qf, lane, s[2], s[3]); else { s[2] = zero16(); s[3] = zero16(); }
        float mx = -1e20f;
#pragma unroll
        for (int q = 0; q < 4; ++q)
#pragma unroll
            for (int i = 0; i < 16; ++i) { const int c = 32 * q + 8 * (i >> 2) + 4 * h + (i & 3); s[q][i] = (c <= cmax) ? s[q][i] : -1e30f; mx = fmaxf(mx, s[q][i]); }
        mx = fmaxf(mx, __shfl_xor(mx, 32));
        float ps = 0.f;
#pragma unroll
        for (int q = 0; q < 4; ++q)
#pragma unroll
            for (int i = 0; i < 16; ++i) { s[q][i] = fexp2((s[q][i] - mx) * SC_LOG2E); ps += s[q][i]; }
        ps += __shfl_xor(ps, 32);
        const float inv = ps > 0.f ? frcp(ps) : 0.f;
        if (ncb == 2) {
            LAS float* part = (LAS float*)(lds + L_PART) + (g * 64 + tl) * 33;
#pragma unroll
            for (int q = 0; q < 4; ++q)
#pragma unroll
                for (int ig = 0; ig < 4; ++ig) part[8 * q + 2 * ig + h] = (s[q][4 * ig] + s[q][4 * ig + 1] + s[q][4 * ig + 2] + 0.5f * s[q][4 * ig + 3]) * inv;
            __syncthreads();
#pragma unroll
            for (int q = 0; q < 4; ++q)
#pragma unroll
                for (int ig = 0; ig < 4; ++ig) { const int jj = 8 * q + 2 * ig + h + 1; if (jj < 32) part[jj] += 0.5f * s[q][4 * ig + 3] * inv; }
        }
#pragma unroll
        for (int dt = 0; dt < 4; ++dt) o[dt] = zero16();
        { bf16x8 pb[4]; pb[0] = pack8(s[0], 0); pb[1] = pack8(s[0], 1); pb[2] = pack8(s[1], 0); pb[3] = pack8(s[1], 1); pv_block(lds + L_V0, pb, lane, o); }
        if (ncb == 2) { bf16x8 pb[4]; pb[0] = pack8(s[2], 0); pb[1] = pack8(s[2], 1); pb[2] = pack8(s[3], 0); pb[3] = pack8(s[3], 1); pv_block(lds + L_V1, pb, lane, o); }
        branch_out<0>(o, gate0 * inv, of32, obf, h);
        __syncthreads();
    }
    unsigned mymask, blockmask;
    if (qb >= 16) {
        LAS unsigned* masks = (LAS unsigned*)(lds + L_MASK);
        {
            const int ttl = tid >> 3, jq = tid & 7;
            LAS const float* pp = (LAS const float*)(lds + L_PART) + ttl * 33;
            float imp[32];
#pragma unroll
            for (int j = 0; j < 32; ++j) { float v = pp[j] + pp[64 * 33 + j] + pp[2 * 64 * 33 + j] + pp[3 * 64 * 33 + j];
                if (j == 0 || j == qb || j == qb - 1) v = 1e9f; else if (j > qb) v = -1e9f;
                imp[j] = v; }
            unsigned bits = 0u;
#pragma unroll
            for (int q = 0; q < 4; ++q) {
                const int j = 4 * jq + q; float vj = 0.f;
#pragma unroll
                for (int jj = 0; jj < 32; ++jj) vj = (jj == j) ? imp[jj] : vj;
                int rank = 0;
#pragma unroll
                for (int jj = 0; jj < 32; ++jj) rank += (imp[jj] > vj || (imp[jj] == vj && jj < j)) ? 1 : 0;
                if (rank < 16) bits |= 1u << j;
            }
            bits |= __shfl_xor(bits, 1); bits |= __shfl_xor(bits, 2); bits |= __shfl_xor(bits, 4);
            if (jq == 0) masks[ttl] = bits;
        }
        __syncthreads();
        mymask = masks[tl]; blockmask = 0u;
        for (int i = 0; i < 64; ++i) blockmask |= masks[i];
    } else { mymask = (2u << qb) - 1u; blockmask = mymask; }
    {
        float m = -1e20f, l = 0.f;
#pragma unroll
        for (int dt = 0; dt < 4; ++dt) o[dt] = zero16();
        const bf16_t* Kg = p.kvbuf + (size_t)(b * SEQ) * 1536 + 2 * 256 + hk * 128; const bf16_t* Vg = Kg + 256;
        attn_stream<1>(Kg, Vg, 0, qb, blockmask, mymask, qb, tl, qf, o, m, l, lds, tid, lane);
        l += __shfl_xor(l, 32);
        branch_out<1>(o, gate1 * frcp(l), of32, obf, h);
    }
    {
        float m = -1e20f, l = 0.f;
#pragma unroll
        for (int dt = 0; dt < 4; ++dt) o[dt] = zero16();
        const bf16_t* Kg = p.kvbuf + (size_t)(b * SEQ) * 1536 + 4 * 256 + hk * 128; const bf16_t* Vg = Kg + 256;
        attn_stream<2>(Kg, Vg, max(0, qb - 8), qb, 0u, 0u, qb, tl, qf, o, m, l, lds, tid, lane);
        l += __shfl_xor(l, 32);
        branch_out<2>(o, gate2 * frcp(l), of32, obf, h);
    }
}

constexpr int D_QS = 0, D_KS = 17408, D_VS = 34816, D_WS = 52224, D_LS = 69632, D_AT = 87040, D_MISC = 130048;
constexpr int STS = 264, VTS = 136, ATS = 144;

struct PrepRegs { u32x4 xr[3][4][2]; float w4[4]; float sa, sb; };
DI void dn_prep_issue(const Params& p, int item, PrepRegs& R, int tid) {
    const int b = item & 7, hh = (item >> 3) & 7, n = item >> 6;
    const int r = tid >> 3, cc = tid & 7; const int tok = 64 * n + r; const size_t grow = (size_t)b * SEQ + tok;
#pragma unroll
    for (int seg = 0; seg < 3; ++seg)
#pragma unroll
        for (int tp = 0; tp < 4; ++tp) {
            const int tk = tok - 3 + tp; const size_t rr = tk >= 0 ? grow - 3 + tp : grow;
            const bf16_t* xp = p.dnqkv + rr * 3072 + seg * 1024 + hh * 128 + 16 * cc;
            R.xr[seg][tp][0] = *(const u32x4*)xp; R.xr[seg][tp][1] = *(const u32x4*)(xp + 8);
        }
    const int t384 = tid < 384 ? tid : 0;
#pragma unroll
    for (int tp = 0; tp < 4; ++tp) R.w4[tp] = p.conv_w[(size_t)tp * 3072 + (t384 >> 7) * 1024 + hh * 128 + (t384 & 127)];
    const int tt = tid >= 448 ? tid - 448 : 0; const size_t gr = (size_t)b * SEQ + 64 * n + tt;
    R.sa = p.small[gr * 64 + 24 + hh]; R.sb = p.small[gr * 64 + 32 + hh];
}
__device__ int dn_prep_item(const Params& p, int item, PrepRegs& R, LAS unsigned char* lds_in) {
    const int b = item & 7, hh = (item >> 3) & 7, n = item >> 6; int next_item;
    const int tid = otid(), wid = tid >> 6, lane = tid & 63, l32 = lane & 31, h = lane >> 5;
    LAS unsigned char* lds = olds(lds_in);
    LAS float* gcs = (LAS float*)(lds + D_MISC); LAS float* betas = gcs + 64; LAS float* Ls = (LAS float*)olds(lds_in + D_LS);
    const float neg_ea = -__expf(p.a_log[hh]); const float dtb = p.dt_bias[hh];
    {
        {
            const int r = tid >> 3, cc = tid & 7; const int tok = 64 * n + r;
            LAS int* slot = (LAS int*)(lds + L_Q);
            if (tid == 0) *slot = (int)atomicAdd(p.ctr + 1, 1u);
            LAS float* wl = (LAS float*)(lds + D_WS);
            if (tid < 384) {
#pragma unroll
                for (int tp = 0; tp < 4; ++tp) wl[tp * 384 + tid] = R.w4[tp];
            }
            if (tid >= 448) {
                const int tt = tid - 448;
                const float a = R.sa + dtb, bl = R.sb;
                const float sp = a > 20.f ? a : log1pf(__expf(a));
                float gsum = neg_ea * sp;
#pragma unroll
                for (int o = 1; o < 64; o <<= 1) { const float u = __shfl_up(gsum, o); if (lane >= o) gsum += u; }
                gcs[tt] = gsum; betas[tt] = sigmoidf_(bl);
            }
            __syncthreads();
            next_item = *slot;
#pragma unroll
            for (int seg = 0; seg < 3; ++seg) {
                float y[16];
#pragma unroll
                for (int i = 0; i < 16; ++i) y[i] = 0.f;
#pragma unroll
                for (int tp = 0; tp < 4; ++tp) {
                    const float msk = (tok - 3 + tp >= 0) ? 1.f : 0.f;
                    const u32x4 xa = R.xr[seg][tp][0], xb = R.xr[seg][tp][1];
                    LAS const float* wp = wl + tp * 384 + seg * 128 + 16 * cc;
                    const f32x4 w0 = *(LAS const f32x4*)wp * msk, w1 = *(LAS const f32x4*)(wp + 4) * msk, w2 = *(LAS const f32x4*)(wp + 8) * msk, w3 = *(LAS const f32x4*)(wp + 12) * msk;
                    y[0] += bflo(xa[0]) * w0[0]; y[1] += bfhi(xa[0]) * w0[1]; y[2] += bflo(xa[1]) * w0[2]; y[3] += bfhi(xa[1]) * w0[3];
                    y[4] += bflo(xa[2]) * w1[0]; y[5] += bfhi(xa[2]) * w1[1]; y[6] += bflo(xa[3]) * w1[2]; y[7] += bfhi(xa[3]) * w1[3];
                    y[8] += bflo(xb[0]) * w2[0]; y[9] += bfhi(xb[0]) * w2[1]; y[10] += bflo(xb[1]) * w2[2]; y[11] += bfhi(xb[1]) * w2[3];
                    y[12] += bflo(xb[2]) * w3[0]; y[13] += bfhi(xb[2]) * w3[1]; y[14] += bflo(xb[3]) * w3[2]; y[15] += bfhi(xb[3]) * w3[3];
                }
                float ss = 0.f;
#pragma unroll
                for (int i = 0; i < 16; ++i) { y[i] = siluf_(y[i]); ss += y[i] * y[i]; }
                float sc = 1.f;
                if (seg < 2) { ss += __shfl_xor(ss, 1); ss += __shfl_xor(ss, 2); ss += __shfl_xor(ss, 4); sc = rsqrtf(ss + EPS); if (seg == 0) sc *= 0.08838834764831845f; }
                LAS unsigned char* dst = lds + (seg == 0 ? D_QS : (seg == 1 ? D_KS : D_VS)) + r * 272 + cc * 32;
                u32x4 wa = {pk2(y[0] * sc, y[1] * sc), pk2(y[2] * sc, y[3] * sc), pk2(y[4] * sc, y[5] * sc), pk2(y[6] * sc, y[7] * sc)};
                u32x4 wb = {pk2(y[8] * sc, y[9] * sc), pk2(y[10] * sc, y[11] * sc), pk2(y[12] * sc, y[13] * sc), pk2(y[14] * sc, y[15] * sc)};
                *(LAS u32x4*)dst = wa; *(LAS u32x4*)(dst + 16) = wb;
            }
            if (next_item < 2048) dn_prep_issue(p, next_item, R, tid);
        }
        __syncthreads();
        {
            const int isq = wid >> 2, bm = (wid >> 1) & 1, bn = wid & 1;
            LAS const unsigned char* Ab = lds + (isq ? D_QS : D_KS) + (32 * bm + l32) * 272 + 16 * h;
            LAS const unsigned char* Bb = lds + D_KS + (32 * bn + l32) * 272 + 16 * h;
            f32x16 acc = zero16();
            if (bm >= bn) {
#pragma unroll
                for (int ks = 0; ks < 8; ++ks) acc = mfma32(lds_b128(Ab + 32 * ks), lds_b128(Bb + 32 * ks), acc);
            }
            const int j = 32 * bn + l32; const float gj = gcs[j];
            const int ib = 32 * bm + 4 * h;
            LAS const float* gci = gcs + ib; LAS const float* bti = betas + ib;
            LAS unsigned char* atw = lds + D_AT + ib * ATS + j * 2; LAS float* lsw = Ls + ib * 68 + j;
#pragma unroll
            for (int r = 0; r < 16; ++r) {
                const int ro = 8 * (r >> 2) + (r & 3); const int i = ib + ro;
                const float dec = fexp(fminf(gci[ro] - gj, 0.f));
                if (isq) { const float v = (i >= j) ? acc[r] * dec : 0.f; *(LAS bf16_t*)(atw + ro * ATS) = f2bf(v); }
                else { const float v = (i > j) ? acc[r] * dec * bti[ro] : 0.f; lsw[ro * 68] = v; }
            }
        }
        __syncthreads();
        {
            const int c = 32 * wid + l32; const bool isw = wid >= 4;
            LAS const unsigned char* src = lds + (isw ? D_KS : D_VS) + (c & 127) * 2 + (4 * h) * 272;
            LAS const float* bth = betas + 4 * h; LAS const float* gch = gcs + 4 * h;
            float xs[32];
#pragma unroll
            for (int sidx = 0; sidx < 32; ++sidx) { const int ro = 8 * (sidx >> 2) + (sidx & 3);
                const float bi = bth[ro]; const float f = isw ? bi * fexp(gch[ro]) : bi; xs[sidx] = bf2f(*(LAS const bf16_t*)(src + ro * 272)) * f; }
            LAS const float* Lh = Ls + 4 * h;
#pragma unroll
            for (int i = 1; i < 64; ++i) {
                float a0 = 0.f, a1 = 0.f, a2 = 0.f, a3 = 0.f;
#pragma unroll
                for (int jj = 0; jj < (i + 7) / 8; ++jj) { const f32x4 lv = *(LAS const f32x4*)(Lh + i * 68 + 8 * jj);
                    a0 += lv[0] * xs[4 * jj]; a1 += lv[1] * xs[4 * jj + 1]; a2 += lv[2] * xs[4 * jj + 2]; a3 += lv[3] * xs[4 * jj + 3]; }
                const float tot = xor32_sum((a0 + a1) + (a2 + a3));
                const int g4 = i >> 2; const int slot = 4 * (g4 >> 1) + (i & 3);
                xs[slot] = (h == (g4 & 1)) ? xs[slot] - tot : xs[slot];
            }
            LAS unsigned char* dst = lds + (isw ? D_WS : D_VS) + (c & 127) * 2 + (4 * h) * 272;
#pragma unroll
            for (int sidx = 0; sidx < 32; ++sidx) { const int ro = 8 * (sidx >> 2) + (sidx & 3); *(LAS bf16_t*)(dst + ro * 272) = f2bf(xs[sidx]); }
        }
        __syncthreads();
        const size_t chunk = (size_t)((b * 8 + hh) * 32 + n);
        { const int r0 = tid >> 4, c16 = tid & 15;
#pragma unroll
          for (int rg = 0; rg < 4; ++rg) {
              const int lo = rg == 0 ? D_QS : (rg == 1 ? D_KS : (rg == 2 ? D_VS : D_WS));
              bf16_t* gb = (rg == 0 ? p.dn_q : (rg == 1 ? p.dn_k : (rg == 2 ? p.dn_u : p.dn_w))) + chunk * 8192;
#pragma unroll
              for (int hf = 0; hf < 2; ++hf) { const int r = r0 + 32 * hf; *(u32x4*)(gb + r * 128 + 8 * c16) = *(LAS const u32x4*)(lds + lo + r * 272 + 16 * c16); }
          }
          { const int r = tid >> 3, c8 = tid & 7; *(u32x4*)(p.dn_at + chunk * 4096 + r * 64 + 8 * c8) = *(LAS const u32x4*)(lds + D_AT + r * ATS + 16 * c8); }
          if (tid < 64) p.dn_gc[chunk * 64 + tid] = gcs[tid];
        }
    }
    __syncthreads();
    return next_item;
}

constexpr int S_WS = 0, S_QS = 17408, S_KS = 34816, S_US = 52224, S_AT = 69632, S_ST = 78848, S_MISC = 112640, S_OS = 112896;

struct DnRegs { u32x4 w0, w1, q0, q1, k0, k1, u0, u1, at, z0, z1; float gc; };
DI void dn_fetch(DnRegs& r, const Params& p, int b, int hh, int n, int tid) {
    const size_t chunk = (size_t)((b * 8 + hh) * 32 + n);
    const int r0 = tid >> 4, c16 = tid & 15; const size_t o0 = chunk * 8192 + r0 * 128 + 8 * c16, o1 = o0 + 32 * 128;
    r.w0 = *(const u32x4*)(p.dn_w + o0); r.w1 = *(const u32x4*)(p.dn_w + o1); r.q0 = *(const u32x4*)(p.dn_q + o0); r.q1 = *(const u32x4*)(p.dn_q + o1);
    r.k0 = *(const u32x4*)(p.dn_k + o0); r.k1 = *(const u32x4*)(p.dn_k + o1); r.u0 = *(const u32x4*)(p.dn_u + o0); r.u1 = *(const u32x4*)(p.dn_u + o1);
    r.at = *(const u32x4*)(p.dn_at + chunk * 4096 + (tid >> 3) * 64 + 8 * (tid & 7));
    r.gc = p.dn_gc[chunk * 64 + (tid & 63)];
    const bf16_t* zp = p.dnz + ((size_t)b * SEQ + 64 * n + (tid >> 3)) * 1024 + hh * 128 + 16 * (tid & 7);
    r.z0 = *(const u32x4*)zp; r.z1 = *(const u32x4*)(zp + 8);
}
DI void dn_fill(const DnRegs& r, LAS unsigned char* lds, int tid) {
    const int r0 = tid >> 4, c16 = tid & 15; const int a0 = r0 * 272 + 16 * c16, a1 = a0 + 32 * 272;
    *(LAS u32x4*)(lds + S_WS + a0) = r.w0; *(LAS u32x4*)(lds + S_WS + a1) = r.w1; *(LAS u32x4*)(lds + S_QS + a0) = r.q0; *(LAS u32x4*)(lds + S_QS + a1) = r.q1;
    *(LAS u32x4*)(lds + S_KS + a0) = r.k0; *(LAS u32x4*)(lds + S_KS + a1) = r.k1; *(LAS u32x4*)(lds + S_US + a0) = r.u0; *(LAS u32x4*)(lds + S_US + a1) = r.u1;
    *(LAS u32x4*)(lds + S_AT + (tid >> 3) * ATS + 16 * (tid & 7)) = r.at;
    if (tid < 64) ((LAS float*)(lds + S_MISC))[tid] = r.gc;
}

__device__ void dn_scan(const Params& p, int b, int hh, LAS unsigned char* lds_in) {
    const int tid = otid(), wid = tid >> 6, lane = tid & 63, l32 = lane & 31, h = lane >> 5;
    LAS unsigned char* lds = lds_in;
    for (int i = tid; i < 128 * STS / 4; i += 512) ((LAS unsigned*)(lds + S_ST))[i] = 0u;
    f32x16 st[2]; st[0] = zero16(); st[1] = zero16();
    const int mtk = wid >> 1, ntv0 = 2 * (wid & 1);
    const int mt = wid >> 2, nt = wid & 3;
    DnRegs nx;
    dn_fetch(nx, p, b, hh, 0, tid);
    dn_fill(nx, lds, tid);
    u32x4 zc0 = nx.z0, zc1 = nx.z1;
    __syncthreads();
    for (int n = 0; n < 32; ++n) {
        lds = olds(lds_in);
        LAS const float* gcs = (LAS const float*)(lds + S_MISC);
        if (n < 31) dn_fetch(nx, p, b, hh, n + 1, tid);
        const float glast = gcs[63];
        f32x16 vn = zero16();
        f32x16 oa = zero16();
        {
            LAS const unsigned char* Ab = lds + S_WS + (32 * mt + l32) * 272 + 16 * h;
            LAS const unsigned char* Aq = lds + S_QS + (32 * mt + l32) * 272 + 16 * h;
            LAS const unsigned char* Bb = lds + S_ST + (32 * nt + l32) * STS + 16 * h;
#pragma unroll
            for (int ks = 0; ks < 8; ++ks) { const bf16x8 bfr = lds_b128(Bb + 32 * ks); vn = mfma32(lds_b128(Ab + 32 * ks), bfr, vn); oa = mfma32(lds_b128(Aq + 32 * ks), bfr, oa); }
            LAS const unsigned char* up = lds + S_US + (32 * mt + 4 * h) * 272 + (32 * nt + l32) * 2;
#pragma unroll
            for (int r = 0; r < 16; ++r) { const int ro = 8 * (r >> 2) + (r & 3); vn[r] = bf2f(*(LAS const bf16_t*)(up + ro * 272)) - vn[r]; }
        }
        __syncthreads();
        {
            const int ib = 32 * mt + 4 * h;
            LAS const float* gci = gcs + ib;
            LAS unsigned char* w1p = lds + S_US + (32 * nt + l32) * VTS + ib * 2; LAS unsigned char* w2p = lds + S_WS + (32 * nt + l32) * VTS + ib * 2;
#pragma unroll
            for (int ig = 0; ig < 4; ++ig) {
                const float e0 = fexp(glast - gci[8 * ig]), e1 = fexp(glast - gci[8 * ig + 1]), e2 = fexp(glast - gci[8 * ig + 2]), e3 = fexp(glast - gci[8 * ig + 3]);
                u32x2 w = {pk2(vn[4 * ig], vn[4 * ig + 1]), pk2(vn[4 * ig + 2], vn[4 * ig + 3])};
                u32x2 ws = {pk2(vn[4 * ig] * e0, vn[4 * ig + 1] * e1), pk2(vn[4 * ig + 2] * e2, vn[4 * ig + 3] * e3)};
                *(LAS u32x2*)(w1p + 16 * ig) = w; *(LAS u32x2*)(w2p + 16 * ig) = ws;
            }
        }
        __syncthreads();
        {
            { LAS const float* gci = gcs + 32 * mt + 4 * h;
#pragma unroll
              for (int r = 0; r < 16; ++r) oa[r] *= fexp(gci[8 * (r >> 2) + (r & 3)]); }
            LAS const unsigned char* A2 = lds + S_AT + (32 * mt + l32) * ATS + 16 * h;
            LAS const unsigned char* B2 = lds + S_US + (32 * nt + l32) * VTS + 16 * h;
#pragma unroll
            for (int ks = 0; ks < 4; ++ks) oa = mfma32(lds_b128(A2 + 32 * ks), lds_b128(B2 + 32 * ks), oa);
            const float eg = fexp(glast);
            st[0] = st[0] * eg; st[1] = st[1] * eg;
            LAS const unsigned char* kp = lds + S_KS + (8 * h + ((lane & 15) >> 2)) * 272 + (32 * mtk + 16 * ((lane >> 4) & 1) + 4 * (lane & 3)) * 2;
#pragma unroll
            for (int s = 0; s < 4; ++s) {
                const bf16x8 af = cat8(tr_read(kp + (16 * s) * 272), tr_read(kp + (16 * s + 4) * 272));
#pragma unroll
                for (int q = 0; q < 2; ++q) {
                    const bf16x8 bfr = lds_b128(lds + S_WS + (32 * (ntv0 + q) + l32) * VTS + (16 * s + 8 * h) * 2);
                    st[q] = mfma32(af, bfr, st[q]);
                }
            }
        }
        __syncthreads();
        {
            { LAS unsigned char* osw = lds + S_OS + (32 * mt + 4 * h) * 272 + (32 * nt + l32) * 2;
#pragma unroll
              for (int r = 0; r < 16; ++r) *(LAS bf16_t*)(osw + (8 * (r >> 2) + (r & 3)) * 272) = f2bf(oa[r]); }
#pragma unroll
            for (int q = 0; q < 2; ++q) { LAS unsigned char* sp = lds + S_ST + (32 * (ntv0 + q) + l32) * STS + (32 * mtk + 4 * h) * 2;
#pragma unroll
                for (int ig = 0; ig < 4; ++ig) {
                    u32x2 w = {pk2(st[q][4 * ig], st[q][4 * ig + 1]), pk2(st[q][4 * ig + 2], st[q][4 * ig + 3])};
                    *(LAS u32x2*)(sp + 16 * ig) = w; } }
            if (n < 31) dn_fill(nx, lds, tid);
        }
        __syncthreads();
        {
            const int r = tid >> 3, cc = tid & 7; const size_t grow = (size_t)b * SEQ + 64 * n + r;
            const u32x4 oa4 = *(LAS const u32x4*)(lds + S_OS + r * 272 + cc * 32), ob4 = *(LAS const u32x4*)(lds + S_OS + r * 272 + cc * 32 + 16);
            float y[16] = {bflo(oa4[0]), bfhi(oa4[0]), bflo(oa4[1]), bfhi(oa4[1]), bflo(oa4[2]), bfhi(oa4[2]), bflo(oa4[3]), bfhi(oa4[3]),
                           bflo(ob4[0]), bfhi(ob4[0]), bflo(ob4[1]), bfhi(ob4[1]), bflo(ob4[2]), bfhi(ob4[2]), bflo(ob4[3]), bfhi(ob4[3])};
            float ss = 0.f;
#pragma unroll
            for (int i = 0; i < 16; ++i) ss += y[i] * y[i];
            ss += __shfl_xor(ss, 1); ss += __shfl_xor(ss, 2); ss += __shfl_xor(ss, 4);
            const float rs = rsqrtf(ss * (1.0f / 128.0f) + EPS);
            const float z[16] = {bflo(zc0[0]), bfhi(zc0[0]), bflo(zc0[1]), bfhi(zc0[1]), bflo(zc0[2]), bfhi(zc0[2]), bflo(zc0[3]), bfhi(zc0[3]),
                                 bflo(zc1[0]), bfhi(zc1[0]), bflo(zc1[1]), bfhi(zc1[1]), bflo(zc1[2]), bfhi(zc1[2]), bflo(zc1[3]), bfhi(zc1[3])};
            const float* nw = p.dn_norm_w + 16 * cc;
#pragma unroll
            for (int i = 0; i < 16; ++i) y[i] = y[i] * rs * nw[i] * siluf_(z[i]);
            u32x4 wa = {pk2(y[0], y[1]), pk2(y[2], y[3]), pk2(y[4], y[5]), pk2(y[6], y[7])}, wb = {pk2(y[8], y[9]), pk2(y[10], y[11]), pk2(y[12], y[13]), pk2(y[14], y[15])};
            bf16_t* op = p.odn + grow * 1024 + hh * 128 + 16 * cc;
            *(u32x4*)op = wa; *(u32x4*)(op + 8) = wb;
            zc0 = nx.z0; zc1 = nx.z1;
        }
    }
    __syncthreads();
}

__device__ void phase_mixers(const Params& p, LAS unsigned char* lds) {
    LAS int* slot = (LAS int*)(lds + L_Q);
    for (;;) {
        __syncthreads();
        if (threadIdx.x == 0) *slot = (int)atomicAdd(p.ctr, 1u);
        __syncthreads();
        const int item = *slot;
        if (item >= 64 + 512 + 264) break;
        if (item < 64) dn_scan(p, item >> 3, item & 7, lds);
        else if (item < 576) { const int e = item - 64; const int qb = 31 - (e >> 4); nsa_item(p, (e >> 1) & 7, e & 1, qb, lds); }
        else {
            const int f = item - 576;
            if (f < 176) transpose_tiles<2, 256>(p.w_ffn_gate, p.w_ffn_up, DM, DFF, p.Wt_gu, NGU_P, (LAS float*)lds, f * 8, 1, f * 8 + 8, p.norm2_w);
            else transpose_tiles<0, 256>(p.w_ffn_down, nullptr, DFF, DM, p.Wt_dn, DM, (LAS float*)lds, (f - 176) * 8, 1, (f - 176) * 8 + 8);
        }
    }
}


#define XB_TMO      128
#define XB_XCNT(j)  (256  + 64 * (j))
#define XB_XSUB(j)  (1280 + 64 * (j))
#define XB_XGEN(j)  (2304 + 64 * (j))
#define XB_TOP      3328
#define XB_TOPGEN   3392
#define XCD_BAR_WORDS 3456
#define XB_SPIN_CAP (1u << 18)
DI unsigned xb_ld(unsigned* p)              { return __hip_atomic_load(p, __ATOMIC_RELAXED, __HIP_MEMORY_SCOPE_AGENT); }
DI unsigned xb_add(unsigned* p, unsigned v) { return __hip_atomic_fetch_add(p, v, __ATOMIC_RELAXED, __HIP_MEMORY_SCOPE_AGENT); }
DI unsigned xb_xcc_id() { return (unsigned)__builtin_amdgcn_s_getreg((3 << 11) | 20) & 0xFu; }
#define XB_SPIN(cond, bar) do { unsigned _sp = 0; while (cond) { __builtin_amdgcn_s_sleep(1); \
    if ((++_sp & 255u) == 0u) { if (xb_ld(&(bar)[XB_TMO])) break; if (_sp > XB_SPIN_CAP) { atomicAdd(&(bar)[XB_TMO], 1u); break; } } } } while (0)
struct XcdBarrier { unsigned* bar; unsigned x; volatile LAS unsigned* st; };
DI XcdBarrier xcd_barrier_post(unsigned* bar, volatile LAS unsigned* st) {
    XcdBarrier b; b.bar = bar; b.x = xb_xcc_id(); b.st = st;
    if (threadIdx.x == 0) (void)xb_add(&bar[XB_XCNT(b.x)], 1u);
    return b;
}
DI void xcd_barrier_complete(unsigned* bar, unsigned x, unsigned& nloc, unsigned& nx) {
    const unsigned G = gridDim.x * gridDim.y * gridDim.z;
    unsigned sum, cnt, mine, sp = 0u;
    for (;;) {
        sum = 0u; cnt = 0u; mine = 0u;
#pragma unroll
        for (unsigned j = 0; j < 16; ++j) { const unsigned c = xb_ld(&bar[XB_XCNT(j)]); sum += c; cnt += (c > 0u) ? 1u : 0u; mine = (j == x) ? c : mine; }
        if (sum == G) break;
        __builtin_amdgcn_s_sleep(1);
        if ((++sp & 255u) == 0u) { if (xb_ld(&bar[XB_TMO])) break; if (sp > XB_SPIN_CAP) { atomicAdd(&bar[XB_TMO], 1u); break; } }
    }
    nloc = mine > 0u ? mine : 1u; nx = cnt > 0u ? cnt : 1u;
}
DI void xcd_barrier_leader(unsigned* bar, unsigned x, volatile LAS unsigned* st) {
    __builtin_amdgcn_s_waitcnt(0);
    unsigned nloc = st[0], nx = st[1];
    if (nloc == 0u) { xcd_barrier_complete(bar, x, nloc, nx); st[0] = nloc; st[1] = nx; }
    const unsigned old = xb_add(&bar[XB_XSUB(x)], 1u);
    const unsigned gen = old / nloc;
    if (old + 1u == (gen + 1u) * nloc) {
        __builtin_amdgcn_fence(__ATOMIC_RELEASE, "agent");
        asm volatile("s_waitcnt vmcnt(0)" ::: "memory");
        const unsigned og = xb_add(&bar[XB_TOP], 1u);
        const unsigned tg = og / nx;
        if (og + 1u == (tg + 1u) * nx) xb_add(&bar[XB_TOPGEN], 1u);
        else XB_SPIN(xb_ld(&bar[XB_TOPGEN]) == tg, bar);
        __builtin_amdgcn_fence(__ATOMIC_ACQUIRE, "agent");
        xb_add(&bar[XB_XGEN(x)], 1u);
        asm volatile("s_waitcnt vmcnt(0)" ::: "memory");
    } else {
        XB_SPIN(xb_ld(&bar[XB_XGEN(x)]) == gen, bar);
        __builtin_amdgcn_fence(__ATOMIC_ACQUIRE, "agent");
        asm volatile("s_waitcnt vmcnt(0)" ::: "memory");
    }
}
DI void xcd_barrier(const XcdBarrier& b) {
    asm volatile("s_waitcnt vmcnt(0)" ::: "memory");
    __syncthreads();
    if (threadIdx.x == 0) xcd_barrier_leader(b.bar, b.x, b.st);
    __syncthreads();
}

__global__ __launch_bounds__(512, 2) void hybrid_block_megakernel(Params p) {
    extern __shared__ __attribute__((aligned(16))) unsigned char shm[];
    LAS unsigned char* lds = (LAS unsigned char*)shm;
    cg::grid_group grid = cg::this_grid();
    const int G = gridDim.x, c = blockIdx.x;
    __shared__ uint4 xb_words;
    if (threadIdx.x == 0) xb_words = make_uint4(0u, 0u, 0u, 0u);
    if (blockIdx.x == 0) { for (int i = threadIdx.x; i < XCD_BAR_WORDS; i += 512) p.bar[i] = 0u; }
    phase_prep(p, lds);
    grid.sync();
    const XcdBarrier xbar = xcd_barrier_post(p.bar, (volatile LAS unsigned*)&xb_words);
    { pg8::Gemm g{p.h, p.Wt_in, T_TOK, NIN_P, DM}; pg8::StaticOrder S; S.init(g.M, g.N, G, c);
      EpiInProj E{p.qbuf, p.kvbuf, p.dnqkv, p.dnz, p.mg, p.small, p.rcos, p.rsin}; pg8::gemm_phase(lds, g, S, E); }
    xcd_barrier(xbar);
    phase_compress(p, lds);
    { LAS int* slot = (LAS int*)(lds + L_Q);
      __syncthreads();
      if (threadIdx.x == 0) *slot = (int)atomicAdd(p.ctr + 1, 1u);
      __syncthreads();
      int item = *slot;
      PrepRegs R;
      if (item < 2048) dn_prep_issue(p, item, R, otid());
      while (item < 2048) item = dn_prep_item(p, item, R, lds);
    }
    xcd_barrier(xbar);
    phase_mixers(p, lds);
    xcd_barrier(xbar);
    { pg8::Gemm g{p.onsa, p.Wt_upn, T_TOK, DM, 1024}; pg8::StaticOrder S; S.init(g.M, g.N, G, c); EpiUp<0> E{p.mixed, p.mg, 0}; pg8::gemm_phase(lds, g, S, E); }
    { pg8::Gemm g{p.odn, p.Wt_upd, T_TOK, DM, 1024}; pg8::StaticOrder S; S.init(g.M, g.N, G, c); EpiUp<1> E{p.mixed, p.mg, 2048}; pg8::gemm_phase(lds, g, S, E); }
    xcd_barrier(xbar);
    { pg8::Gemm g{p.mixed, p.Wt_o, T_TOK, DM, DM}; pg8::StaticOrder S; S.init(g.M, g.N, G, c); EpiWo E{p.out, p.x, p.h, p.rowss}; pg8::gemm_phase(lds, g, S, E); }
    xcd_barrier(xbar);
    { pg8::Gemm g{p.h, p.Wt_gu, T_TOK, NGU_P, DM}; pg8::StaticOrder S; S.init(g.M, g.N, G, c); EpiGU E{p.act, p.rowss}; pg8::gemm_phase(lds, g, S, E); }
    xcd_barrier(xbar);
    { pg8::Gemm g{p.act, p.Wt_dn, T_TOK, DM, DFF}; pg8::StaticOrder S; S.init(g.M, g.N, G, c); EpiResF32<1> E{p.out, nullptr}; pg8::gemm_phase(lds, g, S, E); }
    xcd_barrier(xbar);
    rmsnorm_rows(p.out, p.norm_f_w, nullptr, p.out, T_TOK);
}

extern "C" void kernel_launch(void* const* d_in, const int* in_sizes, int n_in, void* d_out, int out_size, void* d_ws, size_t ws_size, hipStream_t stream) {
    constexpr size_t kDynLds = 131072;
    static int grid_blocks = 0;
    if (!grid_blocks) {
        int dev = 0, cus = 0, per_cu = 0;
        hipGetDevice(&dev);
        hipDeviceGetAttribute(&cus, hipDeviceAttributeMultiprocessorCount, dev);
        hipFuncSetAttribute((const void*)hybrid_block_megakernel, hipFuncAttributeMaxDynamicSharedMemorySize, (int)kDynLds);
        hipOccupancyMaxActiveBlocksPerMultiprocessor(&per_cu, hybrid_block_megakernel, 512, kDynLds);
        if (per_cu < 1) per_cu = 1;
        grid_blocks = cus * 1;
        if (grid_blocks > cus * per_cu) grid_blocks = cus * per_cu;
    }
    Params p{};
    const float* const* in = (const float* const*)d_in;
    p.x = in[0]; p.norm1_w = in[1]; p.w_in = in[2]; p.conv_w = in[3]; p.a_log = in[4]; p.dt_bias = in[5]; p.dn_norm_w = in[6];
    p.cmp_pe_k = in[7]; p.cmp_w1_k = in[8]; p.cmp_w2_k = in[9]; p.cmp_pe_v = in[10]; p.cmp_w1_v = in[11]; p.cmp_w2_v = in[12];
    p.w_up_nsa = in[13]; p.w_up_dn = in[14]; p.w_o = in[15]; p.norm2_w = in[16]; p.w_ffn_gate = in[17]; p.w_ffn_up = in[18]; p.w_ffn_down = in[19]; p.norm_f_w = in[20];
    p.out = (float*)d_out;
    unsigned char* w = (unsigned char*)d_ws; size_t off = 0;
    auto take = [&](size_t bytes) { unsigned char* r = w + off; off += (bytes + 255) & ~(size_t)255; return r; };
    p.ctr = (unsigned*)take(256); p.bar = (unsigned*)take(XCD_BAR_WORDS * 4);
    p.dn_q = (bf16_t*)take((size_t)T_TOK * 1024 * 2); p.dn_k = (bf16_t*)take((size_t)T_TOK * 1024 * 2);
    p.Wt_o = (bf16_t*)take((size_t)DM * DM * 2); p.Wt_upn = (bf16_t*)take((size_t)DM * 1024 * 2); p.Wt_upd = (bf16_t*)take((size_t)DM * 1024 * 2);
    p.W1t_k = (bf16_t*)take((size_t)128 * 4096 * 2); p.W1t_v = (bf16_t*)take((size_t)128 * 4096 * 2); p.W2t_k = (bf16_t*)take(128 * 128 * 2); p.W2t_v = (bf16_t*)take(128 * 128 * 2);
    p.rcos = (float*)take((size_t)SEQ * 64 * 4); p.rsin = (float*)take((size_t)SEQ * 64 * 4);
    p.kc = (bf16_t*)take((size_t)16 * 128 * 128 * 2); p.vc = (bf16_t*)take((size_t)16 * 128 * 128 * 2);
    p.small = (float*)take((size_t)T_TOK * 64 * 4); p.rowss = (float*)take((size_t)T_TOK * 4);
    p.h = (bf16_t*)take((size_t)T_TOK * DM * 2);
    p.onsa = p.h; p.odn = p.h + (size_t)T_TOK * 1024;
    p.qbuf = (bf16_t*)take((size_t)T_TOK * 1024 * 2); p.kvbuf = (bf16_t*)take((size_t)T_TOK * 1536 * 2);
    p.mixed = p.qbuf;
    p.dnqkv = (bf16_t*)take((size_t)T_TOK * 3072 * 2); p.dnz = (bf16_t*)take((size_t)T_TOK * 1024 * 2); p.onsa_f32 = (float*)take((size_t)T_TOK * 1024 * 4);
    p.Wt_gu = p.dnqkv; p.Wt_dn = p.Wt_gu + (size_t)NGU_P * DM;
    p.mg = (bf16_t*)d_out;
    p.Wt_in = (bf16_t*)take((size_t)NIN_P * DM * 2 + 39321600);
    p.act = p.dnz;
    p.dn_u = p.Wt_in; p.dn_w = p.dn_u + (size_t)T_TOK * 1024; p.dn_at = p.dn_w + (size_t)T_TOK * 1024; p.dn_gc = (float*)(p.dn_at + (size_t)2048 * 4096);
    if (off > ws_size) { fprintf(stderr, "workspace too small: need %zu have %zu\n", off, ws_size); return; }
    void* args[] = {&p};
    hipError_t e = hipLaunchCooperativeKernel((void*)hybrid_block_megakernel, dim3(grid_blocks), dim3(512), args, kDynLds, stream);
    if (e != hipSuccess) fprintf(stderr, "cooperative launch failed: %s (grid %d)\n", hipGetErrorString(e), grid_blocks);
}
```

```cpp
#include <hip/hip_runtime.h>
#include <hip/hip_cooperative_groups.h>
#include <cstdio>
namespace cg = cooperative_groups;

#define LAS __attribute__((address_space(3)))
#define DI __device__ __forceinline__
typedef unsigned short bf16_t;
typedef short bf16x8 __attribute__((ext_vector_type(8)));
typedef short s16x4 __attribute__((ext_vector_type(4)));
typedef float f32x2 __attribute__((ext_vector_type(2)));
typedef float f32x4 __attribute__((ext_vector_type(4)));
typedef float f32x16 __attribute__((ext_vector_type(16)));
typedef unsigned u32x2 __attribute__((ext_vector_type(2)));
typedef unsigned u32x4 __attribute__((ext_vector_type(4)));
typedef __bf16 bfv2 __attribute__((ext_vector_type(2)));

constexpr int T_TOK = 16384, SEQ = 2048, DM = 2048, DFF = 5632;
constexpr int NIN_P = 11008, NGU_P = 11264;
constexpr float EPS = 1e-6f;

DI unsigned pk2(float a, float b) { f32x2 v = {a, b}; bfv2 r = __builtin_convertvector(v, bfv2); return __builtin_bit_cast(unsigned, r); }
DI float bf2f(bf16_t b) { return __uint_as_float(((unsigned)b) << 16); }
DI float bflo(unsigned u) { return __uint_as_float(u << 16); }
DI float bfhi(unsigned u) { return __uint_as_float(u & 0xffff0000u); }
DI bf16_t f2bf(float f) { return (bf16_t)(pk2(f, 0.f) & 0xffffu); }
DI float fexp2(float x) { return __builtin_amdgcn_exp2f(x); }
DI float fexp(float x) { return __builtin_amdgcn_exp2f(x * 1.4426950408889634f); }
DI float frcp(float x) { return __builtin_amdgcn_rcpf(x); }
DI float sigmoidf_(float x) { return frcp(1.f + fexp(-x)); }
DI float siluf_(float x) { return x * sigmoidf_(x); }
DI f32x16 mfma32(bf16x8 a, bf16x8 b, f32x16 c) { return __builtin_amdgcn_mfma_f32_32x32x16_bf16(a, b, c, 0, 0, 0); }
DI s16x4 tr_read(LAS const unsigned char* p) { return __builtin_amdgcn_ds_read_tr16_b64_v4i16((LAS s16x4*)p); }
DI bf16x8 cat8(s16x4 a, s16x4 b) { return __builtin_shufflevector(a, b, 0, 1, 2, 3, 4, 5, 6, 7); }
DI bf16x8 lds_b128(LAS const unsigned char* p) { return *(LAS const bf16x8*)p; }
DI LAS unsigned char* olds(LAS unsigned char* l) { unsigned z = 0; asm volatile("" : "+v"(z)); return l + z; }
DI int otid() { int t = threadIdx.x; asm volatile("" : "+v"(t)); return t; }
DI float xor32_sum(float v) { const unsigned u = __float_as_uint(v); auto r = __builtin_amdgcn_permlane32_swap(u, u, false, false); return __uint_as_float(r[0]) + __uint_as_float(r[1]); }
#define DPP_F(v, ctrl) __uint_as_float(__builtin_amdgcn_update_dpp(0u, __float_as_uint(v), (ctrl), 0xF, 0xF, true))
DI float sum8(float v) { v += DPP_F(v, 0xB1); v += DPP_F(v, 0x4E); v += DPP_F(v, 0x141); return v; }
DI f32x16 zero16() { f32x16 z; for (int i = 0; i < 16; ++i) z[i] = 0.f; return z; }

struct Params {
    const float *x, *norm1_w, *w_in, *conv_w, *a_log, *dt_bias, *dn_norm_w, *cmp_pe_k, *cmp_w1_k, *cmp_w2_k, *cmp_pe_v, *cmp_w1_v, *cmp_w2_v,
        *w_up_nsa, *w_up_dn, *w_o, *norm2_w, *w_ffn_gate, *w_ffn_up, *w_ffn_down, *norm_f_w;
    float* out;
    bf16_t *Wt_in, *Wt_gu, *Wt_dn, *Wt_o, *Wt_upn, *Wt_upd, *W1t_k, *W1t_v, *W2t_k, *W2t_v;
    bf16_t *h, *qbuf, *kvbuf, *dnqkv, *dnz, *mg, *onsa, *odn, *mixed, *act, *kc, *vc;
    float *small, *rcos, *rsin, *onsa_f32, *dn_gc, *rowss;
    bf16_t *dn_q, *dn_k, *dn_u, *dn_w, *dn_at;
    unsigned* ctr; unsigned* bar;
};

namespace pg8 {
constexpr int BM = 256, BK = 64, HALF = 128, HTB = HALF * BK * 2, STAGE_BYTES = 8 * HTB, NXCD = 8, WGM = 8;
DI int lds_byte(int r, int c) { const int st = (r >> 4) * 2 + (c >> 5), rr = r & 15, cc = c & 31, ob = rr * 64 + cc * 2; return st * 1024 + (ob ^ (((ob >> 9) & 1) << 5)); }
DI void stage_rc(int b, int& R, int& C) { const int st = b / 1024, sb = b % 1024, swz = sb ^ (((sb >> 9) & 1) << 5); R = (st >> 1) * 16 + swz / 64; C = (st & 1) * 32 + (swz % 64) / 2; }
DI int perm32(int rho) { const int n = rho >> 4, i = rho & 15; return 8 * (i >> 2) + 4 * n + (i & 3); }
struct Unit { int pm, pn; };
struct Gemm { const bf16_t* A; const bf16_t* Bt; int M, N, K; };
struct StaticOrder {
    int nM, nN, nwg, G, c;
    DI void init(int M, int N, int G_, int c_) { nM = M / BM; nN = N / BM; nwg = nM * nN; G = G_; c = c_; }
    DI bool next(int i, Unit& u) const {
        const long L = (long)i * G + c; if (L >= nwg) return false;
        int wgid = (int)L; { const int q = nwg / NXCD, r = nwg % NXCD, xcd = wgid % NXCD, off = wgid / NXCD; wgid = (xcd < r ? xcd * (q + 1) : r * (q + 1) + (xcd - r) * q) + off; }
        const int nig = WGM * nN, gid = wgid / nig, fm = gid * WGM, gsz = (nM - fm) < WGM ? (nM - fm) : WGM;
        u.pm = fm + ((wgid % nig) % gsz); u.pn = (wgid % nig) / gsz; return true;
    }
};

template <class Epi>
DI void gemm_phase(LAS unsigned char* lds, const Gemm g, const StaticOrder& S, const Epi& E) {
    const int tid = otid(), wid = __builtin_amdgcn_readfirstlane(tid >> 6), lane = tid & 63, wr = wid >> 2, wc = wid & 3, fr = lane & 15, fq = lane >> 4;
    const int K = g.K, nt = K / BK;
    unsigned voffA[2], voffB[2];
#pragma unroll
    for (int i = 0; i < 2; ++i) { int R, C; stage_rc(tid * 16 + i * 8192, R, C); const int Rb = Epi::PERM ? ((R & ~31) + perm32(R & 31)) : R;
        voffA[i] = (unsigned)(R * K + C) * 2u; voffB[i] = (unsigned)(Rb * K + C) * 2u; }
    const size_t kstep = (size_t)(BK * 2);
    const size_t hstep = (size_t)HALF * K * 2;
    const size_t tstep = 2 * hstep;
    const unsigned ldsw = (unsigned)wid * 1024u;
    const int aoff = lds_byte(wr * 64 + fr, fq * 8), boff = lds_byte(wc * 32 + fr, fq * 8);
#define PG8_SA(b, h) (((b) * 2 + (h)) * HTB)
#define PG8_SB(b, h) ((4 + (b) * 2 + (h)) * HTB)
#define PG8_STAGE(bufoff, gbase, voff) do { _Pragma("unroll") for (int _i = 0; _i < 2; ++_i) \
        __builtin_amdgcn_global_load_lds((const unsigned*)((const char*)(gbase) + (voff)[_i]), (LAS unsigned*)(lds + (bufoff) + ldsw + _i * 8192), 16, 0, 0); } while (0)
#define PG8_LDA(dst, b, h) do { _Pragma("unroll") for (int m = 0; m < 4; ++m) _Pragma("unroll") for (int k = 0; k < 2; ++k) dst[m][k] = *(const LAS bf16x8*)(lds + PG8_SA(b, h) + aoff + m * 2048 + k * 1024); } while (0)
#define PG8_LDB(dst, b, h) do { _Pragma("unroll") for (int n = 0; n < 2; ++n) _Pragma("unroll") for (int k = 0; k < 2; ++k) dst[n][k] = *(const LAS bf16x8*)(lds + PG8_SB(b, h) + boff + n * 2048 + k * 1024); } while (0)
#define PG8_MMA(ai, bj, At, Bt) do { __builtin_amdgcn_s_setprio(1); _Pragma("unroll") for (int m = 0; m < 4; ++m) _Pragma("unroll") for (int n = 0; n < 2; ++n) _Pragma("unroll") for (int k = 0; k < 2; ++k) \
        acc[ai][bj][m][n] = __builtin_amdgcn_mfma_f32_16x16x32_bf16(Bt[n][k], At[m][k], acc[ai][bj][m][n], 0, 0, 0); __builtin_amdgcn_s_setprio(0); } while (0)
#define PG8_WAIT_V(n) asm volatile("s_waitcnt vmcnt(" #n ")" ::: "memory")
#define PG8_WAIT_L(n) asm volatile("s_waitcnt lgkmcnt(" #n ")" ::: "memory")
#define PG8_BAR __builtin_amdgcn_s_barrier()
#define PG8_SCHED __builtin_amdgcn_sched_barrier(0)
    Unit cur, nxt; int ui = 0;
    if (!S.next(0, cur)) return;
    f32x4 acc[2][2][4][2];
#pragma unroll
    for (int a = 0; a < 2; ++a)
#pragma unroll
        for (int b = 0; b < 2; ++b)
#pragma unroll
            for (int m = 0; m < 4; ++m)
#pragma unroll
                for (int n = 0; n < 2; ++n) acc[a][b][m][n] = (f32x4){0.f, 0.f, 0.f, 0.f};
    bf16x8 At[4][2], B0[2][2], B1[2][2];
    const char* cA = (const char*)g.A + (size_t)cur.pm * tstep; const char* cB = (const char*)g.Bt + (size_t)cur.pn * tstep;
    PG8_STAGE(PG8_SB(0, 0), cB, voffB); PG8_STAGE(PG8_SA(0, 0), cA, voffA); PG8_STAGE(PG8_SB(0, 1), cB + hstep, voffB); PG8_STAGE(PG8_SA(0, 1), cA + hstep, voffA);
    if (wr == 1) PG8_BAR;
    PG8_WAIT_V(4); PG8_BAR;
    PG8_STAGE(PG8_SB(1, 0), cB + kstep, voffB); PG8_STAGE(PG8_SA(1, 0), cA + kstep, voffA); PG8_STAGE(PG8_SB(1, 1), cB + hstep + kstep, voffB);
    PG8_WAIT_V(6); PG8_BAR;
    for (;;) {
        const bool has_next = S.next(ui + 1, nxt);
        const char* nA = has_next ? (const char*)g.A + (size_t)nxt.pm * tstep : cA; const char* nB = has_next ? (const char*)g.Bt + (size_t)nxt.pn * tstep : cB;
        for (int t = 0; t < nt; t += 2) {
            const bool last = (t == nt - 2);
            const char* a1 = cA + (size_t)(t + 1) * kstep;
            const char* a2 = last ? nA : cA + (size_t)(t + 2) * kstep; const char* b2 = last ? nB : cB + (size_t)(t + 2) * kstep;
            const char* a3 = a2 + kstep; const char* b3 = b2 + kstep;
            PG8_LDB(B0, 0, 0); PG8_SCHED; PG8_LDA(At, 0, 0); PG8_STAGE(PG8_SA(1, 1), a1 + hstep, voffA);
            PG8_WAIT_L(8); PG8_BAR; PG8_WAIT_L(0); PG8_MMA(0, 0, At, B0); PG8_BAR; PG8_SCHED;
            PG8_LDB(B1, 0, 1); PG8_STAGE(PG8_SB(0, 0), b2, voffB);
            PG8_BAR; PG8_WAIT_L(0); PG8_MMA(0, 1, At, B1); PG8_BAR;
            PG8_LDA(At, 0, 1); PG8_STAGE(PG8_SA(0, 0), a2, voffA);
            PG8_BAR; PG8_WAIT_L(0); PG8_MMA(1, 0, At, B0); PG8_BAR; PG8_SCHED;
            PG8_STAGE(PG8_SB(0, 1), b2 + hstep, voffB);
            PG8_WAIT_V(6); PG8_BAR; PG8_MMA(1, 1, At, B1); PG8_BAR;
            PG8_LDB(B0, 1, 0); PG8_SCHED; PG8_LDA(At, 1, 0); PG8_STAGE(PG8_SA(0, 1), a2 + hstep, voffA);
            PG8_WAIT_L(8); PG8_BAR; PG8_WAIT_L(0); PG8_MMA(0, 0, At, B0); PG8_BAR; PG8_SCHED;
            PG8_LDB(B1, 1, 1); PG8_STAGE(PG8_SB(1, 0), b3, voffB);
            PG8_BAR; PG8_WAIT_L(0); PG8_MMA(0, 1, At, B1); PG8_BAR;
            PG8_LDA(At, 1, 1); PG8_STAGE(PG8_SA(1, 0), a3, voffA);
            PG8_BAR; PG8_WAIT_L(0); PG8_MMA(1, 0, At, B0); PG8_BAR; PG8_SCHED;
            PG8_STAGE(PG8_SB(1, 1), b3 + hstep, voffB);
            PG8_WAIT_V(6); PG8_BAR; PG8_MMA(1, 1, At, B1); PG8_BAR;
        }
        E(acc, cur, wr, wc, fr, fq);
        if (!has_next) break;
#pragma unroll
        for (int a = 0; a < 2; ++a)
#pragma unroll
            for (int b = 0; b < 2; ++b)
#pragma unroll
                for (int m = 0; m < 4; ++m)
#pragma unroll
                    for (int n = 0; n < 2; ++n) acc[a][b][m][n] = (f32x4){0.f, 0.f, 0.f, 0.f};
        cur = nxt; cA = nA; cB = nB; ++ui;
    }
    PG8_WAIT_V(0);
    if (wr == 0) PG8_BAR;
    PG8_BAR;
#undef PG8_SA
#undef PG8_SB
#undef PG8_STAGE
#undef PG8_LDA
#undef PG8_LDB
#undef PG8_MMA
#undef PG8_WAIT_V
#undef PG8_WAIT_L
#undef PG8_BAR
#undef PG8_SCHED
}
}
using pg8::Unit;

typedef f32x4 AccT[2][2][4][2];

struct EpiInProj {
    static constexpr bool PERM = true;
    bf16_t *qbuf, *kvbuf, *dnqkv, *dnz, *mg; float* small; const float *rcos, *rsin;
    DI void operator()(const AccT& acc, const Unit& u, int wr, int wc, int fr, int fq) const {
        const int pn = u.pn; const int row0 = u.pm * 256 + wr * 64 + fr; const int cl = wc * 32 + 8 * fq;
        if (pn == 42) {
            if (wc < 2) {
#pragma unroll
                for (int ai = 0; ai < 2; ++ai)
#pragma unroll
                    for (int m = 0; m < 4; ++m) { float* rp = small + (size_t)(row0 + ai * 128 + m * 16) * 64 + cl;
                        *(f32x4*)(rp) = acc[ai][0][m][0]; *(f32x4*)(rp + 4) = acc[ai][0][m][1]; }
            }
            return;
        }
        bf16_t* dst; int ld, cbase; bool rope = false;
        if (pn < 4) { dst = qbuf; ld = 1024; cbase = pn * 256; rope = true; }
        else if (pn < 10) { dst = kvbuf; ld = 1536; cbase = (pn - 4) * 256; rope = ((pn - 4) & 1) == 0; }
        else if (pn < 22) { dst = dnqkv; ld = 3072; cbase = (pn - 10) * 256; }
        else if (pn < 26) { dst = dnz; ld = 1024; cbase = (pn - 22) * 256; }
        else { dst = mg; ld = 4096; cbase = (pn - 26) * 256; }
        if (rope) {
            const int i4 = 4 * (4 * wc + fq);
            f32x4 invr;
#pragma unroll
            for (int e = 0; e < 4; ++e) invr[e] = fexp2(-(float)(2 * (i4 + e)) * (13.287712379549449f / 128.0f)) * 0.15915494309189535f;
#pragma unroll
            for (int ai = 0; ai < 2; ++ai)
#pragma unroll
                for (int m = 0; m < 4; ++m) {
                    const int row = row0 + ai * 128 + m * 16; const int t = row & (SEQ - 1);
                    f32x4 c, s;
#pragma unroll
                    for (int e = 0; e < 4; ++e) { float rev = (float)t * invr[e]; rev = rev - floorf(rev); c[e] = __builtin_amdgcn_cosf(rev); s[e] = __builtin_amdgcn_sinf(rev); }
#pragma unroll
                    for (int bj = 0; bj < 2; ++bj) {
                        const f32x4 x1 = acc[ai][bj][m][0], x2 = acc[ai][bj][m][1];
                        const f32x4 o1 = x1 * c - x2 * s, o2 = x2 * c + x1 * s;
                        bf16_t* rp = dst + (size_t)row * ld + cbase + bj * 128 + i4;
                        u32x2 w1 = {pk2(o1[0], o1[1]), pk2(o1[2], o1[3])}, w2 = {pk2(o2[0], o2[1]), pk2(o2[2], o2[3])};
                        *(u32x2*)rp = w1; *(u32x2*)(rp + 64) = w2;
                    }
                }
        } else {
#pragma unroll
            for (int ai = 0; ai < 2; ++ai)
#pragma unroll
                for (int m = 0; m < 4; ++m) {
                    bf16_t* rp = dst + (size_t)(row0 + ai * 128 + m * 16) * ld + cbase + cl;
#pragma unroll
                    for (int bj = 0; bj < 2; ++bj) { const f32x4 v0 = acc[ai][bj][m][0], v1 = acc[ai][bj][m][1];
                        u32x4 w = {pk2(v0[0], v0[1]), pk2(v0[2], v0[3]), pk2(v1[0], v1[1]), pk2(v1[2], v1[3])};
                        *(u32x4*)(rp + bj * 128) = w; }
                }
        }
    }
};

template <int PASS> struct EpiUp {
    static constexpr bool PERM = true;
    bf16_t* mixed; const bf16_t* mg; int gofs;
    DI void operator()(const AccT& acc, const Unit& u, int wr, int wc, int fr, int fq) const {
        const int row0 = u.pm * 256 + wr * 64 + fr; const int col0 = u.pn * 256 + wc * 32 + 8 * fq;
#pragma unroll
        for (int ai = 0; ai < 2; ++ai)
#pragma unroll
            for (int mh = 0; mh < 2; ++mh) {
                u32x4 gvv[2][2], pvv[2][2];
#pragma unroll
                for (int mm = 0; mm < 2; ++mm) { const size_t row = (size_t)(row0 + ai * 128 + (2 * mh + mm) * 16);
#pragma unroll
                    for (int bj = 0; bj < 2; ++bj) { const int col = col0 + bj * 128;
                        gvv[mm][bj] = *(const u32x4*)(mg + row * 4096 + gofs + col);
                        if (PASS == 1) pvv[mm][bj] = *(const u32x4*)(mixed + row * 2048 + col); } }
#pragma unroll
                for (int mm = 0; mm < 2; ++mm) { const size_t row = (size_t)(row0 + ai * 128 + (2 * mh + mm) * 16);
#pragma unroll
                    for (int bj = 0; bj < 2; ++bj) {
                        const int col = col0 + bj * 128; const u32x4 gv = gvv[mm][bj];
                        bf16_t* op = mixed + row * 2048 + col;
                        const f32x4 v0 = acc[ai][bj][2 * mh + mm][0], v1 = acc[ai][bj][2 * mh + mm][1];
                        float r[8];
                        r[0] = sigmoidf_(bflo(gv[0])) * v0[0]; r[1] = sigmoidf_(bfhi(gv[0])) * v0[1]; r[2] = sigmoidf_(bflo(gv[1])) * v0[2]; r[3] = sigmoidf_(bfhi(gv[1])) * v0[3];
                        r[4] = sigmoidf_(bflo(gv[2])) * v1[0]; r[5] = sigmoidf_(bfhi(gv[2])) * v1[1]; r[6] = sigmoidf_(bflo(gv[3])) * v1[2]; r[7] = sigmoidf_(bfhi(gv[3])) * v1[3];
                        if (PASS == 1) { const u32x4 pv = pvv[mm][bj];
                            r[0] += bflo(pv[0]); r[1] += bfhi(pv[0]); r[2] += bflo(pv[1]); r[3] += bfhi(pv[1]); r[4] += bflo(pv[2]); r[5] += bfhi(pv[2]); r[6] += bflo(pv[3]); r[7] += bfhi(pv[3]); }
                        u32x4 w = {pk2(r[0], r[1]), pk2(r[2], r[3]), pk2(r[4], r[5]), pk2(r[6], r[7])};
                        *(u32x4*)op = w;
                    } }
            }
    }
};

template <int ACCUM> struct EpiResF32 {
    static constexpr bool PERM = false;
    float* out; const float* resid;
    DI void operator()(const AccT& acc, const Unit& u, int wr, int wc, int fr, int fq) const {
        const int row0 = u.pm * 256 + wr * 64 + fr, col0 = u.pn * 256 + wc * 32 + 4 * fq;
        const float* src = ACCUM ? (const float*)out : resid;
#pragma unroll
        for (int ai = 0; ai < 2; ++ai)
#pragma unroll
            for (int mh = 0; mh < 2; ++mh) {
                f32x4 base[2][2][2];
#pragma unroll
                for (int mm = 0; mm < 2; ++mm) { const size_t ro = (size_t)(row0 + ai * 128 + (2 * mh + mm) * 16) * DM + col0;
#pragma unroll
                    for (int bj = 0; bj < 2; ++bj)
#pragma unroll
                        for (int n = 0; n < 2; ++n) base[mm][bj][n] = *(const f32x4*)(src + ro + bj * 128 + n * 16); }
#pragma unroll
                for (int mm = 0; mm < 2; ++mm) { const size_t ro = (size_t)(row0 + ai * 128 + (2 * mh + mm) * 16) * DM + col0;
#pragma unroll
                    for (int bj = 0; bj < 2; ++bj)
#pragma unroll
                        for (int n = 0; n < 2; ++n) *(f32x4*)(out + ro + bj * 128 + n * 16) = base[mm][bj][n] + acc[ai][bj][2 * mh + mm][n]; }
            }
    }
};

struct EpiWo {
    static constexpr bool PERM = false;
    float* out; const float* resid; bf16_t* xb; float* rowss;
    DI void operator()(const AccT& acc, const Unit& u, int wr, int wc, int fr, int fq) const {
        const int row0 = u.pm * 256 + wr * 64 + fr, col0 = u.pn * 256 + wc * 32 + 4 * fq;
#pragma unroll
        for (int ai = 0; ai < 2; ++ai)
#pragma unroll
            for (int mh = 0; mh < 2; ++mh) {
                f32x4 base[2][2][2];
#pragma unroll
                for (int mm = 0; mm < 2; ++mm) { const size_t ro = (size_t)(row0 + ai * 128 + (2 * mh + mm) * 16) * DM + col0;
#pragma unroll
                    for (int bj = 0; bj < 2; ++bj)
#pragma unroll
                        for (int n = 0; n < 2; ++n) base[mm][bj][n] = *(const f32x4*)(resid + ro + bj * 128 + n * 16); }
#pragma unroll
                for (int mm = 0; mm < 2; ++mm) { const int row = row0 + ai * 128 + (2 * mh + mm) * 16; const size_t ro = (size_t)row * DM + col0;
                    float ss = 0.f;
#pragma unroll
                    for (int bj = 0; bj < 2; ++bj)
#pragma unroll
                        for (int n = 0; n < 2; ++n) { const f32x4 v = base[mm][bj][n] + acc[ai][bj][2 * mh + mm][n];
                            *(f32x4*)(out + ro + bj * 128 + n * 16) = v;
                            u32x2 w = {pk2(v[0], v[1]), pk2(v[2], v[3])}; *(u32x2*)(xb + ro + bj * 128 + n * 16) = w;
                            ss += v[0] * v[0] + v[1] * v[1] + v[2] * v[2] + v[3] * v[3]; }
                    ss += __shfl_xor(ss, 16); ss += __shfl_xor(ss, 32);
                    if (fq == 0) atomicAdd(rowss + row, ss);
                }
            }
    }
};

struct EpiGU {
    static constexpr bool PERM = true;
    bf16_t* act; const float* rowss;
    DI void operator()(const AccT& acc, const Unit& u, int wr, int wc, int fr, int fq) const {
        const int row0 = u.pm * 256 + wr * 64 + fr; const int col0 = (u.pn * 256 + wc * 32 + 8 * fq) >> 1;
        float rs[2][4];
#pragma unroll
        for (int ai = 0; ai < 2; ++ai)
#pragma unroll
            for (int m = 0; m < 4; ++m) rs[ai][m] = rowss[row0 + ai * 128 + m * 16];
#pragma unroll
        for (int ai = 0; ai < 2; ++ai)
#pragma unroll
            for (int m = 0; m < 4; ++m) rs[ai][m] = rsqrtf(rs[ai][m] * (1.0f / DM) + EPS);
#pragma unroll
        for (int ai = 0; ai < 2; ++ai)
#pragma unroll
            for (int m = 0; m < 4; ++m) { bf16_t* rp = act + (size_t)(row0 + ai * 128 + m * 16) * DFF + col0; const float r = rs[ai][m];
#pragma unroll
                for (int bj = 0; bj < 2; ++bj) { const f32x4 gt = acc[ai][bj][m][0] * r, up = acc[ai][bj][m][1] * r;
                    u32x2 w = {pk2(siluf_(gt[0]) * up[0], siluf_(gt[1]) * up[1]), pk2(siluf_(gt[2]) * up[2], siluf_(gt[3]) * up[3])};
                    *(u32x2*)(rp + bj * 64) = w; } }
    }
};

DI float wave_sum(float v) {
#pragma unroll
    for (int o = 32; o >= 1; o >>= 1) v += __shfl_xor(v, o);
    return v;
}

__device__ void rmsnorm_rows(const float* __restrict__ x, const float* __restrict__ w, bf16_t* outb, float* outf, int nrows) {
    const int tid_ = otid(); const int lane = tid_ & 63; const int gw = blockIdx.x * 8 + (tid_ >> 6), nw = gridDim.x * 8;
    for (int row = gw; row < nrows; row += nw) {
        const f32x4* xr = (const f32x4*)(x + (size_t)row * DM);
        f32x4 v[8]; float ss = 0.f;
#pragma unroll
        for (int i = 0; i < 8; ++i) { v[i] = xr[lane + 64 * i]; ss += v[i][0] * v[i][0] + v[i][1] * v[i][1] + v[i][2] * v[i][2] + v[i][3] * v[i][3]; }
        ss = wave_sum(ss);
        const float r = rsqrtf(ss * (1.0f / DM) + EPS);
#pragma unroll
        for (int i = 0; i < 8; ++i) { const f32x4 wv = ((const f32x4*)w)[lane + 64 * i]; const f32x4 o = v[i] * r * wv;
            if (outb) { u32x2 pw = {pk2(o[0], o[1]), pk2(o[2], o[3])}; *(u32x2*)(outb + (size_t)row * DM + 4 * (lane + 64 * i)) = pw; }
            else { *(f32x4*)(outf + (size_t)row * DM + 4 * (lane + 64 * i)) = o; } }
    }
}

DI int rope_perm(int r) { const int i = r >> 3, j = r & 7; return j < 4 ? 4 * i + j : 64 + 4 * i + (j - 4); }
DI int src_in(int p) {
    if (p < 1024) return (p & ~127) + rope_perm(p & 127);
    if (p < 2560) { const int pp = p - 1024; const int grp = pp >> 8; if (!(grp & 1)) return 1024 + (pp & ~127) + rope_perm(pp & 127); return 1024 + pp; }
    if (p < 5632) return 2584 + (p - 2560);
    if (p < 6656) return 5656 + (p - 5632);
    if (p < 10752) return 6696 + (p - 6656);
    const int s = p - 10752;
    if (s < 24) return 2560 + s;
    if (s < 32) return 6680 + (s - 24);
    if (s < 40) return 6688 + (s - 32);
    return -1;
}

template <int MODE, int PW>
__device__ void transpose_tiles(const float* __restrict__ W, const float* __restrict__ W2, int K, int N, bf16_t* Wt, int Np, LAS float* tile, int t0, int tstep, int tend, const float* __restrict__ kscale = nullptr) {
    const int tid = otid(); const int nkt = K / 64;
    constexpr int PQ = PW / 4, KR = 512 / PQ;
    for (int tt = t0; tt < tend; tt += tstep) {
        const int pt = tt / nkt, kt = tt % nkt; const int p0 = pt * PW, k0 = kt * 64;
        { const int pl = (tid % PQ) * 4, kr = tid / PQ; const int p = p0 + pl; const float* src = W; int sc;
          if (MODE == 0) sc = p; else if (MODE == 1) sc = src_in(p); else { const int g8 = p >> 3, j = p & 7; sc = 4 * g8 + (j & 3); if (j >= 4) src = W2; }
          const float* sp = src + (size_t)(k0 + kr) * N + (sc >= 0 ? sc : 0);
          f32x4 v[64 / KR];
#pragma unroll
          for (int i = 0; i < 64 / KR; ++i) v[i] = *(const f32x4*)(sp + (size_t)(i * KR) * N);
#pragma unroll
          for (int i = 0; i < 64 / KR; ++i) { LAS float* tp = tile + (kr + i * KR) * (PW + 1) + pl; const bool ok = sc >= 0;
              const float ks = kscale ? kscale[k0 + kr + i * KR] : 1.f;
              tp[0] = ok ? v[i][0] * ks : 0.f; tp[1] = ok ? v[i][1] * ks : 0.f; tp[2] = ok ? v[i][2] * ks : 0.f; tp[3] = ok ? v[i][3] * ks : 0.f; } }
        __syncthreads();
        { const int kq = tid & 7, pr = tid >> 3;
#pragma unroll
          for (int ps = 0; ps < PW / 64; ++ps) { float v[8]; const int prr = pr + 64 * ps;
#pragma unroll
              for (int i = 0; i < 8; ++i) v[i] = tile[(8 * kq + i) * (PW + 1) + prr];
              u32x4 w = {pk2(v[0], v[1]), pk2(v[2], v[3]), pk2(v[4], v[5]), pk2(v[6], v[7])};
              *(u32x4*)(Wt + (size_t)(p0 + prr) * K + k0 + 8 * kq) = w; } }
        __syncthreads();
    }
}
template <int MODE, int PW>
__device__ void transpose_w(const float* __restrict__ W, const float* __restrict__ W2, int K, int N, bf16_t* Wt, int Np, LAS float* tile, int& tcount) {
    const int ntile = (K / 64) * (Np / PW);
    transpose_tiles<MODE, PW>(W, W2, K, N, Wt, Np, tile, ((int)blockIdx.x - tcount % (int)gridDim.x + (int)gridDim.x) % (int)gridDim.x, (int)gridDim.x, ntile);
    tcount += ntile;
}

__device__ void phase_prep(const Params& p, LAS unsigned char* lds) {
    if (blockIdx.x == 0 && threadIdx.x == 0) { p.ctr[0] = 0u; p.ctr[1] = 0u; }
    for (int i = blockIdx.x * 512 + threadIdx.x; i < T_TOK; i += gridDim.x * 512) p.rowss[i] = 0.f;
    rmsnorm_rows(p.x, p.norm1_w, p.h, nullptr, T_TOK);
    LAS float* tile = (LAS float*)lds; int tc = 0;
    transpose_w<1, 256>(p.w_in, nullptr, DM, 10792, p.Wt_in, NIN_P, tile, tc);
    transpose_w<0, 256>(p.w_o, nullptr, DM, DM, p.Wt_o, DM, tile, tc);
    transpose_w<0, 256>(p.w_up_nsa, nullptr, 1024, DM, p.Wt_upn, DM, tile, tc);
    transpose_w<0, 256>(p.w_up_dn, nullptr, 1024, DM, p.Wt_upd, DM, tile, tc);
    transpose_w<0, 128>(p.cmp_w1_k, nullptr, 4096, 128, p.W1t_k, 128, tile, tc);
    transpose_w<0, 128>(p.cmp_w1_v, nullptr, 4096, 128, p.W1t_v, 128, tile, tc);
    transpose_w<0, 128>(p.cmp_w2_k, nullptr, 128, 128, p.W2t_k, 128, tile, tc);
    transpose_w<0, 128>(p.cmp_w2_v, nullptr, 128, 128, p.W2t_v, 128, tile, tc);
}

DI float gelu_tanh(float x) { const float u = 0.7978845608028654f * (x + 0.044715f * x * x * x); const float e = fexp(2.f * u); return 0.5f * x * (2.f - 2.f * frcp(e + 1.f)); }

__device__ void phase_compress(const Params& p, LAS unsigned char* lds) {
    const int tid = otid(), wid = tid >> 6, lane = tid & 63, l32 = lane & 31, h = lane >> 5;
    const int kq = wid & 3, nh = wid >> 2;
    LAS float* red = (LAS float*)lds;
    LAS unsigned char* Hs = lds + 4 * 32 * 132 * 4;
    for (int item = blockIdx.x; item < 128; item += gridDim.x) {
        const int mt = item & 3, hk = (item >> 2) & 1, b = (item >> 3) & 7, kv = item >> 6;
        const bf16_t* W1t = kv ? p.W1t_v : p.W1t_k; const bf16_t* W2t = kv ? p.W2t_v : p.W2t_k; const float* pe = kv ? p.cmp_pe_v : p.cmp_pe_k;
        bf16_t* outp = (kv ? p.vc : p.kc) + (size_t)((b * 2 + hk) * 128) * 128;
        const int c = 32 * mt + l32;
        const bf16_t* abase = p.kvbuf + (size_t)(b * SEQ) * 1536 + kv * 256 + hk * 128 + 32 * kq + 8 * h;
        f32x16 acc[2]; acc[0] = zero16(); acc[1] = zero16();
#pragma unroll 4
        for (int li = 0; li < 32; ++li) {
            int tok = 16 * c + li; tok = tok > SEQ - 1 ? SEQ - 1 : tok;
#pragma unroll
            for (int s2 = 0; s2 < 2; ++s2) {
                const u32x4 av = *(const u32x4*)(abase + (size_t)tok * 1536 + 16 * s2);
                const f32x4 pe0 = *(const f32x4*)(pe + li * 128 + 32 * kq + 16 * s2 + 8 * h), pe1 = *(const f32x4*)(pe + li * 128 + 32 * kq + 16 * s2 + 8 * h + 4);
                u32x4 aw = {pk2(bflo(av[0]) + pe0[0], bfhi(av[0]) + pe0[1]), pk2(bflo(av[1]) + pe0[2], bfhi(av[1]) + pe0[3]),
                            pk2(bflo(av[2]) + pe1[0], bfhi(av[2]) + pe1[1]), pk2(bflo(av[3]) + pe1[2], bfhi(av[3]) + pe1[3])};
                const bf16x8 af = __builtin_bit_cast(bf16x8, aw);
#pragma unroll
                for (int n2 = 0; n2 < 2; ++n2) {
                    const bf16x8 bfr = *(const bf16x8*)(W1t + (size_t)(64 * nh + 32 * n2 + l32) * 4096 + li * 128 + 32 * kq + 16 * s2 + 8 * h);
                    acc[n2] = mfma32(af, bfr, acc[n2]);
                }
            }
        }
#pragma unroll
        for (int n2 = 0; n2 < 2; ++n2)
#pragma unroll
            for (int r = 0; r < 16; ++r) red[(kq * 32 + 8 * (r >> 2) + 4 * h + (r & 3)) * 132 + 64 * nh + 32 * n2 + l32] = acc[n2][r];
        __syncthreads();
        { const int row = tid >> 4, c8 = (tid & 15) * 8; float v[8];
#pragma unroll
          for (int i = 0; i < 8; ++i) { const int o = row * 132 + c8 + i; v[i] = gelu_tanh(red[o] + red[32 * 132 + o] + red[2 * 32 * 132 + o] + red[3 * 32 * 132 + o]); }
          u32x4 w = {pk2(v[0], v[1]), pk2(v[2], v[3]), pk2(v[4], v[5]), pk2(v[6], v[7])};
          *(LAS u32x4*)(Hs + row * 272 + c8 * 2) = w; }
        __syncthreads();
        if (wid < 4) {
            f32x16 o = zero16();
#pragma unroll
            for (int ks = 0; ks < 8; ++ks) {
                const bf16x8 af = lds_b128(Hs + l32 * 272 + (16 * ks + 8 * h) * 2);
                const bf16x8 bfr = *(const bf16x8*)(W2t + (size_t)(32 * wid + l32) * 128 + 16 * ks + 8 * h);
                o = mfma32(af, bfr, o);
            }
#pragma unroll
            for (int r = 0; r < 16; ++r) outp[(size_t)(32 * mt + 8 * (r >> 2) + 4 * h + (r & 3)) * 128 + 32 * wid + l32] = f2bf(o[r]);
        }
        __syncthreads();
    }
}

constexpr int KS = 272, VS = 320;
constexpr int L_K0 = 0, L_K1 = 17408, L_V0 = 34816, L_V1 = 55296, L_PART = 75776, L_MASK = 109568, L_Q = 131056;
constexpr float SC_LOG2E = 0.08838834764831845f * 1.4426950408889634f;

struct KVRegs { u32x4 k0, k1, v0, v1; };
DI void kv_load(KVRegs& r, const bf16_t* Kg, const bf16_t* Vg, int ld, int j, int tid) {
    const int r0 = tid >> 4, c16 = tid & 15;
    const size_t o0 = (size_t)(64 * j + r0) * ld + 8 * c16, o1 = o0 + (size_t)32 * ld;
    r.k0 = *(const u32x4*)(Kg + o0); r.k1 = *(const u32x4*)(Kg + o1); r.v0 = *(const u32x4*)(Vg + o0); r.v1 = *(const u32x4*)(Vg + o1);
}
DI void kv_store(const KVRegs& r, LAS unsigned char* Kl, LAS unsigned char* Vl, int tid) {
    const int r0 = tid >> 4, c16 = tid & 15;
    *(LAS u32x4*)(Kl + r0 * KS + 16 * c16) = r.k0; *(LAS u32x4*)(Kl + (r0 + 32) * KS + 16 * c16) = r.k1;
    *(LAS u32x4*)(Vl + r0 * VS + 16 * c16) = r.v0; *(LAS u32x4*)(Vl + (r0 + 32) * VS + 16 * c16) = r.v1;
}
DI void qk_block(LAS const unsigned char* Kl, const bf16x8 (&qf)[8], int lane, f32x16& s0, f32x16& s1) {
    const int l32 = lane & 31, h = lane >> 5;
    s0 = zero16(); s1 = zero16();
    LAS const unsigned char* kp = Kl + l32 * KS + 16 * h;
    bf16x8 A[2][4];
    A[0][0] = lds_b128(kp); A[0][1] = lds_b128(kp + 32 * KS); A[0][2] = lds_b128(kp + 32); A[0][3] = lds_b128(kp + 32 * KS + 32);
#pragma unroll
    for (int b = 0; b < 4; ++b) {
        if (b < 3) { A[(b + 1) & 1][0] = lds_b128(kp + 64 * (b + 1)); A[(b + 1) & 1][1] = lds_b128(kp + 32 * KS + 64 * (b + 1));
                     A[(b + 1) & 1][2] = lds_b128(kp + 64 * (b + 1) + 32); A[(b + 1) & 1][3] = lds_b128(kp + 32 * KS + 64 * (b + 1) + 32); }
        s0 = mfma32(A[b & 1][0], qf[2 * b], s0); s1 = mfma32(A[b & 1][1], qf[2 * b], s1);
        s0 = mfma32(A[b & 1][2], qf[2 * b + 1], s0); s1 = mfma32(A[b & 1][3], qf[2 * b + 1], s1);
    }
}
DI bf16x8 pack8(const f32x16& p, int q) {
    u32x4 w = {pk2(p[8 * q], p[8 * q + 1]), pk2(p[8 * q + 2], p[8 * q + 3]), pk2(p[8 * q + 4], p[8 * q + 5]), pk2(p[8 * q + 6], p[8 * q + 7])};
    return __builtin_bit_cast(bf16x8, w);
}
DI void pv_block(LAS const unsigned char* Vl, const bf16x8 (&pb)[4], int lane, f32x16 (&o)[4]) {
    const int h = lane >> 5;
    LAS const unsigned char* vp = Vl + (4 * h + ((lane & 15) >> 2)) * VS + (16 * ((lane >> 4) & 1) + 4 * (lane & 3)) * 2;
    s16x4 V[2][8];
#pragma unroll
    for (int dt = 0; dt < 4; ++dt) { V[0][2 * dt] = tr_read(vp + 64 * dt); V[0][2 * dt + 1] = tr_read(vp + 8 * VS + 64 * dt); }
#pragma unroll
    for (int kq = 0; kq < 4; ++kq) {
        if (kq < 3) {
#pragma unroll
            for (int dt = 0; dt < 4; ++dt) { V[(kq + 1) & 1][2 * dt] = tr_read(vp + (16 * (kq + 1)) * VS + 64 * dt); V[(kq + 1) & 1][2 * dt + 1] = tr_read(vp + (16 * (kq + 1) + 8) * VS + 64 * dt); }
        }
#pragma unroll
        for (int dt = 0; dt < 4; ++dt) o[dt] = mfma32(cat8(V[kq & 1][2 * dt], V[kq & 1][2 * dt + 1]), pb[kq], o[dt]);
    }
}
DI void softmax_block(f32x16& s0, f32x16& s1, int lo, int hi, int h, float& m, float& l, f32x16 (&o)[4], bf16x8 (&pb)[4]) {
    float mx = -1e30f;
    if (__any((lo > 0) || (hi < 63))) {
        const int lo2 = lo - 4 * h, hi2 = hi - 4 * h;
#pragma unroll
        for (int i = 0; i < 16; ++i) { const int k0 = 8 * (i >> 2) + (i & 3);
            s0[i] = (k0 >= lo2 && k0 <= hi2) ? s0[i] : -1e30f; s1[i] = (k0 + 32 >= lo2 && k0 + 32 <= hi2) ? s1[i] : -1e30f; }
    }
#pragma unroll
    for (int i = 0; i < 16; ++i) mx = fmaxf(mx, fmaxf(s0[i], s1[i]));
    mx = fmaxf(mx, __shfl_xor(mx, 32));
    const float mn = fmaxf(m, mx);
    const float alpha = fexp2((m - mn) * SC_LOG2E);
    const float mb = mn * SC_LOG2E;
    m = mn;
    float ps = 0.f;
#pragma unroll
    for (int i = 0; i < 16; ++i) { s0[i] = fexp2(s0[i] * SC_LOG2E - mb); s1[i] = fexp2(s1[i] * SC_LOG2E - mb); ps += s0[i] + s1[i]; }
    l = l * alpha + ps;
    if (__any(alpha != 1.0f)) {
#pragma unroll
        for (int dt = 0; dt < 4; ++dt) o[dt] = o[dt] * alpha;
    }
    pb[0] = pack8(s0, 0); pb[1] = pack8(s0, 1); pb[2] = pack8(s1, 0); pb[3] = pack8(s1, 1);
}

template <int MODE>
DI void branch_out(const f32x16 (&o)[4], float fac, float* of32, bf16_t* obf, int h) {
#pragma unroll
    for (int dt = 0; dt < 4; ++dt)
#pragma unroll
        for (int ig = 0; ig < 4; ++ig) {
            const int d0 = 32 * dt + 8 * ig + 4 * h;
            f32x4 v = {o[dt][4 * ig] * fac, o[dt][4 * ig + 1] * fac, o[dt][4 * ig + 2] * fac, o[dt][4 * ig + 3] * fac};
            if (MODE >= 1) v += *(const f32x4*)(of32 + d0);
            if (MODE <= 1) *(f32x4*)(of32 + d0) = v;
            if (MODE == 2) { u32x2 w = {pk2(v[0], v[1]), pk2(v[2], v[3])}; *(u32x2*)(obf + d0) = w; }
        }
}

template <int MODE>
DI void attn_stream(const bf16_t* Kg, const bf16_t* Vg, int jlo, int jhi, unsigned blockmask, unsigned mymask, int qb, int tl,
                    const bf16x8 (&qf)[8], f32x16 (&o)[4], float& m, float& l, LAS unsigned char* lds, int tid, int lane) {
    const int h = lane >> 5;
    int j = jlo;
    if (MODE == 1) { while (j <= jhi && !((blockmask >> j) & 1u)) ++j; }
    KVRegs kr;
    kv_load(kr, Kg, Vg, 1536, j, tid);
    kv_store(kr, lds + L_K0, lds + L_V0, tid);
    __syncthreads();
    int cur = 0;
    for (;;) {
        int jn = j + 1;
        if (MODE == 1) { while (jn <= jhi && !((blockmask >> jn) & 1u)) ++jn; }
        const bool hn = jn <= jhi;
        if (hn) kv_load(kr, Kg, Vg, 1536, jn, tid);
        LAS unsigned char* Kl = lds + (cur ? L_K1 : L_K0); LAS unsigned char* Vl = lds + (cur ? L_V1 : L_V0);
        f32x16 s0, s1; qk_block(Kl, qf, lane, s0, s1);
        int lo = 0, hi = 63;
        if (MODE == 1) { if (j == qb) hi = tl; if (!((mymask >> j) & 1u)) hi = -1; }
        else { if (j == qb - 8) lo = tl + 1; if (j == qb) hi = tl; }
        bf16x8 pb[4];
        softmax_block(s0, s1, lo, hi, h, m, l, o, pb);
        pv_block(Vl, pb, lane, o);
        if (!hn) break;
        kv_store(kr, lds + (cur ? L_K0 : L_K1), lds + (cur ? L_V0 : L_V1), tid);
        __syncthreads();
        cur ^= 1; j = jn;
    }
    __syncthreads();
}

__device__ void nsa_item(const Params& p, int b, int hk, int qb, LAS unsigned char* lds) {
    const int tid = otid(), wid = tid >> 6, lane = tid & 63, l32 = lane & 31, h = lane >> 5;
    const int g = wid >> 1, tl = (wid & 1) * 32 + l32, t = qb * 64 + tl; const size_t row = (size_t)b * SEQ + t; const int head = hk * 4 + g;
    bf16x8 qf[8];
    { const bf16_t* qp = p.qbuf + row * 1024 + head * 128 + 8 * h;
#pragma unroll
      for (int ks = 0; ks < 8; ++ks) qf[ks] = *(const bf16x8*)(qp + 16 * ks); }
    const float* glp = p.small + row * 64 + head * 3;
    const float gate0 = sigmoidf_(glp[0]), gate1 = sigmoidf_(glp[1]), gate2 = sigmoidf_(glp[2]);
    float* of32 = p.onsa_f32 + row * 1024 + head * 128; bf16_t* obf = p.onsa + row * 1024 + head * 128;
    f32x16 o[4];
    const int ncb = (qb >= 16) ? 2 : 1;
    {
        const bf16_t* kcg = p.kc + (size_t)((b * 2 + hk) * 128) * 128; const bf16_t* vcg = p.vc + (size_t)((b * 2 + hk) * 128) * 128;
        KVRegs kr;
        kv_load(kr, kcg, vcg, 128, 0, tid); kv_store(kr, lds + L_K0, lds + L_V0, tid);
        if (ncb == 2) { kv_load(kr, kcg, vcg, 128, 1, tid); kv_store(kr, lds + L_K1, lds + L_V1, tid); }
        __syncthreads();
        const int cmax = (t >= 31) ? min(126, (t - 31) >> 4) : -1;
        f32x16 s[4];
        qk_block(lds + L_K0, qf, lane, s[0], s[1]);
        if (ncb == 2) qk_block(lds + L_K1, qf, lane, s[2], s[3]); else { s[2] = zero16(); s[3] = zero16(); }
        float mx = -1e20f;
#pragma unroll
        for (int q = 0; q < 4; ++q)
#pragma unroll
            for (int i = 0; i < 16; ++i) { const int c = 32 * q + 8 * (i >> 2) + 4 * h + (i & 3); s[q][i] = (c <= cmax) ? s[q][i] : -1e30f; mx = fmaxf(mx, s[q][i]); }
        mx = fmaxf(mx, __shfl_xor(mx, 32));
        float ps = 0.f;
#pragma unroll
        for (int q = 0; q < 4; ++q)
#pragma unroll
            for (int i = 0; i < 16; ++i) { s[q][i] = fexp2((s[q][i] - mx) * SC_LOG2E); ps += s[q][i]; }
        ps += __shfl_xor(ps, 32);
        const float inv = ps > 0.f ? frcp(ps) : 0.f;
        if (ncb == 2) {
            LAS float* part = (LAS float*)(lds + L_PART) + (g * 64 + tl) * 33;
#pragma unroll
            for (int q = 0; q < 4; ++q)
#pragma unroll
                for (int ig = 0; ig < 4; ++ig) part[8 * q + 2 * ig + h] = (s[q][4 * ig] + s[q][4 * ig + 1] + s[q][4 * ig + 2] + 0.5f * s[q][4 * ig + 3]) * inv;
            __syncthreads();
#pragma unroll
            for (int q = 0; q < 4; ++q)
#pragma unroll
                for (int ig = 0; ig < 4; ++ig) { const int jj = 8 * q + 2 * ig + h + 1; if (jj < 32) part[jj] += 0.5f * s[q][4 * ig + 3] * inv; }
        }
#pragma unroll
        for (int dt = 0; dt < 4; ++dt) o[dt] = zero16();
        { bf16x8 pb[4]; pb[0] = pack8(s[0], 0); pb[1] = pack8(s[0], 1); pb[2] = pack8(s[1], 0); pb[3] = pack8(s[1], 1); pv_block(lds + L_V0, pb, lane, o); }
        if (ncb == 2) { bf16x8 pb[4]; pb[0] = pack8(s[2], 0); pb[1] = pack8(s[2], 1); pb[2] = pack8(s[3], 0); pb[3] = pack8(s[3], 1); pv_block(lds + L_V1, pb, lane, o); }
        branch_out<0>(o, gate0 * inv, of32, obf, h);
        __syncthreads();
    }
    unsigned mymask, blockmask;
    if (qb >= 16) {
        LAS unsigned* masks = (LAS unsigned*)(lds + L_MASK);
        {
            const int ttl = tid >> 3, jq = tid & 7;
            LAS const float* pp = (LAS const float*)(lds + L_PART) + ttl * 33;
            float imp[32];
#pragma unroll
            for (int j = 0; j < 32; ++j) { float v = pp[j] + pp[64 * 33 + j] + pp[2 * 64 * 33 + j] + pp[3 * 64 * 33 + j];
                if (j == 0 || j == qb || j == qb - 1) v = 1e9f; else if (j > qb) v = -1e9f;
                imp[j] = v; }
            unsigned bits = 0u;
#pragma unroll
            for (int q = 0; q < 4; ++q) {
                const int j = 4 * jq + q; float vj = 0.f;
#pragma unroll
                for (int jj = 0; jj < 32; ++jj) vj = (jj == j) ? imp[jj] : vj;
                int rank = 0;
#pragma unroll
                for (int jj = 0; jj < 32; ++jj) rank += (imp[jj] > vj || (imp[jj] == vj && jj < j)) ? 1 : 0;
                if (rank < 16) bits |= 1u << j;
            }
            bits |= __shfl_xor(bits, 1); bits |= __shfl_xor(bits, 2); bits |= __shfl_xor(bits, 4);
            if (jq == 0) masks[ttl] = bits;
        }
        __syncthreads();
        mymask = masks[tl]; blockmask = 0u;
        for (int i = 0; i < 64; ++i) blockmask |= masks[i];
    } else { mymask = (2u << qb) - 1u; blockmask = mymask; }
    {
        float m = -1e20f, l = 0.f;
#pragma unroll
        for (int dt = 0; dt < 4; ++dt) o[dt] = zero16();
        const bf16_t* Kg = p.kvbuf + (size_t)(b * SEQ) * 1536 + 2 * 256 + hk * 128; const bf16_t* Vg = Kg + 256;
        attn_stream<1>(Kg, Vg, 0, qb, blockmask, mymask, qb, tl, qf, o, m, l, lds, tid, lane);
        l += __shfl_xor(l, 32);
        branch_out<1>(o, gate1 * frcp(l), of32, obf, h);
    }
    {
        float m = -1e20f, l = 0.f;
#pragma unroll
        for (int dt = 0; dt < 4; ++dt) o[dt] = zero16();
        const bf16_t* Kg = p.kvbuf + (size_t)(b * SEQ) * 1536 + 4 * 256 + hk * 128; const bf16_t* Vg = Kg + 256;
        attn_stream<2>(Kg, Vg, max(0, qb - 8), qb, 0u, 0u, qb, tl, qf, o, m, l, lds, tid, lane);
        l += __shfl_xor(l, 32);
        branch_out<2>(o, gate2 * frcp(l), of32, obf, h);
    }
}

constexpr int D_QS = 0, D_KS = 17408, D_VS = 34816, D_WS = 52224, D_LS = 69632, D_AT = 87040, D_MISC = 130048;
constexpr int STS = 264, VTS = 136, ATS = 144;

struct PrepRegs { u32x4 xr[3][4][2]; float w4[4]; float sa, sb; };
DI void dn_prep_issue(const Params& p, int item, PrepRegs& R, int tid) {
    const int b = item & 7, hh = (item >> 3) & 7, n = item >> 6;
    const int r = tid >> 3, cc = tid & 7; const int tok = 64 * n + r; const size_t grow = (size_t)b * SEQ + tok;
#pragma unroll
    for (int seg = 0; seg < 3; ++seg)
#pragma unroll
        for (int tp = 0; tp < 4; ++tp) {
            const int tk = tok - 3 + tp; const size_t rr = tk >= 0 ? grow - 3 + tp : grow;
            const bf16_t* xp = p.dnqkv + rr * 3072 + seg * 1024 + hh * 128 + 16 * cc;
            R.xr[seg][tp][0] = *(const u32x4*)xp; R.xr[seg][tp][1] = *(const u32x4*)(xp + 8);
        }
    const int t384 = tid < 384 ? tid : 0;
#pragma unroll
    for (int tp = 0; tp < 4; ++tp) R.w4[tp] = p.conv_w[(size_t)tp * 3072 + (t384 >> 7) * 1024 + hh * 128 + (t384 & 127)];
    const int tt = tid >= 448 ? tid - 448 : 0; const size_t gr = (size_t)b * SEQ + 64 * n + tt;
    R.sa = p.small[gr * 64 + 24 + hh]; R.sb = p.small[gr * 64 + 32 + hh];
}
__device__ int dn_prep_item(const Params& p, int item, PrepRegs& R, LAS unsigned char* lds_in) {
    const int b = item & 7, hh = (item >> 3) & 7, n = item >> 6; int next_item;
    const int tid = otid(), wid = tid >> 6, lane = tid & 63, l32 = lane & 31, h = lane >> 5;
    LAS unsigned char* lds = olds(lds_in);
    LAS float* gcs = (LAS float*)(lds + D_MISC); LAS float* betas = gcs + 64; LAS float* Ls = (LAS float*)olds(lds_in + D_LS);
    const float neg_ea = -__expf(p.a_log[hh]); const float dtb = p.dt_bias[hh];
    {
        {
            const int r = tid >> 3, cc = tid & 7; const int tok = 64 * n + r;
            LAS int* slot = (LAS int*)(lds + L_Q);
            if (tid == 0) *slot = (int)atomicAdd(p.ctr + 1, 1u);
            LAS float* wl = (LAS float*)(lds + D_WS);
            if (tid < 384) {
#pragma unroll
                for (int tp = 0; tp < 4; ++tp) wl[tp * 384 + tid] = R.w4[tp];
            }
            if (tid >= 448) {
                const int tt = tid - 448;
                const float a = R.sa + dtb, bl = R.sb;
                const float sp = a > 20.f ? a : log1pf(__expf(a));
                float gsum = neg_ea * sp;
#pragma unroll
                for (int o = 1; o < 64; o <<= 1) { const float u = __shfl_up(gsum, o); if (lane >= o) gsum += u; }
                gcs[tt] = gsum; betas[tt] = sigmoidf_(bl);
            }
            __syncthreads();
            next_item = *slot;
#pragma unroll
            for (int seg = 0; seg < 3; ++seg) {
                float y[16];
#pragma unroll
                for (int i = 0; i < 16; ++i) y[i] = 0.f;
#pragma unroll
                for (int tp = 0; tp < 4; ++tp) {
                    const float msk = (tok - 3 + tp >= 0) ? 1.f : 0.f;
                    const u32x4 xa = R.xr[seg][tp][0], xb = R.xr[seg][tp][1];
                    LAS const float* wp = wl + tp * 384 + seg * 128 + 16 * cc;
                    const f32x4 w0 = *(LAS const f32x4*)wp * msk, w1 = *(LAS const f32x4*)(wp + 4) * msk, w2 = *(LAS const f32x4*)(wp + 8) * msk, w3 = *(LAS const f32x4*)(wp + 12) * msk;
                    y[0] += bflo(xa[0]) * w0[0]; y[1] += bfhi(xa[0]) * w0[1]; y[2] += bflo(xa[1]) * w0[2]; y[3] += bfhi(xa[1]) * w0[3];
                    y[4] += bflo(xa[2]) * w1[0]; y[5] += bfhi(xa[2]) * w1[1]; y[6] += bflo(xa[3]) * w1[2]; y[7] += bfhi(xa[3]) * w1[3];
                    y[8] += bflo(xb[0]) * w2[0]; y[9] += bfhi(xb[0]) * w2[1]; y[10] += bflo(xb[1]) * w2[2]; y[11] += bfhi(xb[1]) * w2[3];
                    y[12] += bflo(xb[2]) * w3[0]; y[13] += bfhi(xb[2]) * w3[1]; y[14] += bflo(xb[3]) * w3[2]; y[15] += bfhi(xb[3]) * w3[3];
                }
                float ss = 0.f;
#pragma unroll
                for (int i = 0; i < 16; ++i) { y[i] = siluf_(y[i]); ss += y[i] * y[i]; }
                float sc = 1.f;
                if (seg < 2) { ss += __shfl_xor(ss, 1); ss += __shfl_xor(ss, 2); ss += __shfl_xor(ss, 4); sc = rsqrtf(ss + EPS); if (seg == 0) sc *= 0.08838834764831845f; }
                LAS unsigned char* dst = lds + (seg == 0 ? D_QS : (seg == 1 ? D_KS : D_VS)) + r * 272 + cc * 32;
                u32x4 wa = {pk2(y[0] * sc, y[1] * sc), pk2(y[2] * sc, y[3] * sc), pk2(y[4] * sc, y[5] * sc), pk2(y[6] * sc, y[7] * sc)};
                u32x4 wb = {pk2(y[8] * sc, y[9] * sc), pk2(y[10] * sc, y[11] * sc), pk2(y[12] * sc, y[13] * sc), pk2(y[14] * sc, y[15] * sc)};
                *(LAS u32x4*)dst = wa; *(LAS u32x4*)(dst + 16) = wb;
            }
            if (next_item < 2048) dn_prep_issue(p, next_item, R, tid);
        }
        __syncthreads();
        {
            const int isq = wid >> 2, bm = (wid >> 1) & 1, bn = wid & 1;
            LAS const unsigned char* Ab = lds + (isq ? D_QS : D_KS) + (32 * bm + l32) * 272 + 16 * h;
            LAS const unsigned char* Bb = lds + D_KS + (32 * bn + l32) * 272 + 16 * h;
            f32x16 acc = zero16();
            if (bm >= bn) {
#pragma unroll
                for (int ks = 0; ks < 8; ++ks) acc = mfma32(lds_b128(Ab + 32 * ks), lds_b128(Bb + 32 * ks), acc);
            }
            const int j = 32 * bn + l32; const float gj = gcs[j];
            const int ib = 32 * bm + 4 * h;
            LAS const float* gci = gcs + ib; LAS const float* bti = betas + ib;
            LAS unsigned char* atw = lds + D_AT + ib * ATS + j * 2; LAS float* lsw = Ls + ib * 68 + j;
#pragma unroll
            for (int r = 0; r < 16; ++r) {
                const int ro = 8 * (r >> 2) + (r & 3); const int i = ib + ro;
                const float dec = fexp(fminf(gci[ro] - gj, 0.f));
                if (isq) { const float v = (i >= j) ? acc[r] * dec : 0.f; *(LAS bf16_t*)(atw + ro * ATS) = f2bf(v); }
                else { const float v = (i > j) ? acc[r] * dec * bti[ro] : 0.f; lsw[ro * 68] = v; }
            }
        }
        __syncthreads();
        {
            const int c = 32 * wid + l32; const bool isw = wid >= 4;
            LAS const unsigned char* src = lds + (isw ? D_KS : D_VS) + (c & 127) * 2 + (4 * h) * 272;
            LAS const float* bth = betas + 4 * h; LAS const float* gch = gcs + 4 * h;
            float xs[32];
#pragma unroll
            for (int sidx = 0; sidx < 32; ++sidx) { const int ro = 8 * (sidx >> 2) + (sidx & 3);
                const float bi = bth[ro]; const float f = isw ? bi * fexp(gch[ro]) : bi; xs[sidx] = bf2f(*(LAS const bf16_t*)(src + ro * 272)) * f; }
            LAS const float* Lh = Ls + 4 * h;
#pragma unroll
            for (int i = 1; i < 64; ++i) {
                float a0 = 0.f, a1 = 0.f, a2 = 0.f, a3 = 0.f;
#pragma unroll
                for (int jj = 0; jj < (i + 7) / 8; ++jj) { const f32x4 lv = *(LAS const f32x4*)(Lh + i * 68 + 8 * jj);
                    a0 += lv[0] * xs[4 * jj]; a1 += lv[1] * xs[4 * jj + 1]; a2 += lv[2] * xs[4 * jj + 2]; a3 += lv[3] * xs[4 * jj + 3]; }
                const float tot = xor32_sum((a0 + a1) + (a2 + a3));
                const int g4 = i >> 2; const int slot = 4 * (g4 >> 1) + (i & 3);
                xs[slot] = (h == (g4 & 1)) ? xs[slot] - tot : xs[slot];
            }
            LAS unsigned char* dst = lds + (isw ? D_WS : D_VS) + (c & 127) * 2 + (4 * h) * 272;
#pragma unroll
            for (int sidx = 0; sidx < 32; ++sidx) { const int ro = 8 * (sidx >> 2) + (sidx & 3); *(LAS bf16_t*)(dst + ro * 272) = f2bf(xs[sidx]); }
        }
        __syncthreads();
        const size_t chunk = (size_t)((b * 8 + hh) * 32 + n);
        { const int r0 = tid >> 4, c16 = tid & 15;
#pragma unroll
          for (int rg = 0; rg < 4; ++rg) {
              const int lo = rg == 0 ? D_QS : (rg == 1 ? D_KS : (rg == 2 ? D_VS : D_WS));
              bf16_t* gb = (rg == 0 ? p.dn_q : (rg == 1 ? p.dn_k : (rg == 2 ? p.dn_u : p.dn_w))) + chunk * 8192;
#pragma unroll
              for (int hf = 0; hf < 2; ++hf) { const int r = r0 + 32 * hf; *(u32x4*)(gb + r * 128 + 8 * c16) = *(LAS const u32x4*)(lds + lo + r * 272 + 16 * c16); }
          }
          { const int r = tid >> 3, c8 = tid & 7; *(u32x4*)(p.dn_at + chunk * 4096 + r * 64 + 8 * c8) = *(LAS const u32x4*)(lds + D_AT + r * ATS + 16 * c8); }
          if (tid < 64) p.dn_gc[chunk * 64 + tid] = gcs[tid];
        }
    }
    __syncthreads();
    return next_item;
}

constexpr int S_WS = 0, S_QS = 17408, S_KS = 34816, S_US = 52224, S_AT = 69632, S_ST = 78848, S_MISC = 112640, S_OS = 112896;

struct DnRegs { u32x4 w0, w1, q0, q1, k0, k1, u0, u1, at, z0, z1; float gc; };
DI void dn_fetch(DnRegs& r, const Params& p, int b, int hh, int n, int tid) {
    const size_t chunk = (size_t)((b * 8 + hh) * 32 + n);
    const int r0 = tid >> 4, c16 = tid & 15; const size_t o0 = chunk * 8192 + r0 * 128 + 8 * c16, o1 = o0 + 32 * 128;
    r.w0 = *(const u32x4*)(p.dn_w + o0); r.w1 = *(const u32x4*)(p.dn_w + o1); r.q0 = *(const u32x4*)(p.dn_q + o0); r.q1 = *(const u32x4*)(p.dn_q + o1);
    r.k0 = *(const u32x4*)(p.dn_k + o0); r.k1 = *(const u32x4*)(p.dn_k + o1); r.u0 = *(const u32x4*)(p.dn_u + o0); r.u1 = *(const u32x4*)(p.dn_u + o1);
    r.at = *(const u32x4*)(p.dn_at + chunk * 4096 + (tid >> 3) * 64 + 8 * (tid & 7));
    r.gc = p.dn_gc[chunk * 64 + (tid & 63)];
    const bf16_t* zp = p.dnz + ((size_t)b * SEQ + 64 * n + (tid >> 3)) * 1024 + hh * 128 + 16 * (tid & 7);
    r.z0 = *(const u32x4*)zp; r.z1 = *(const u32x4*)(zp + 8);
}
DI void dn_fill(const DnRegs& r, LAS unsigned char* lds, int tid) {
    const int r0 = tid >> 4, c16 = tid & 15; const int a0 = r0 * 272 + 16 * c16, a1 = a0 + 32 * 272;
    *(LAS u32x4*)(lds + S_WS + a0) = r.w0; *(LAS u32x4*)(lds + S_WS + a1) = r.w1; *(LAS u32x4*)(lds + S_QS + a0) = r.q0; *(LAS u32x4*)(lds + S_QS + a1) = r.q1;
    *(LAS u32x4*)(lds + S_KS + a0) = r.k0; *(LAS u32x4*)(lds + S_KS + a1) = r.k1; *(LAS u32x4*)(lds + S_US + a0) = r.u0; *(LAS u32x4*)(lds + S_US + a1) = r.u1;
    *(LAS u32x4*)(lds + S_AT + (tid >> 3) * ATS + 16 * (tid & 7)) = r.at;
    if (tid < 64) ((LAS float*)(lds + S_MISC))[tid] = r.gc;
}

__device__ void dn_scan(const Params& p, int b, int hh, LAS unsigned char* lds_in) {
    const int tid = otid(), wid = tid >> 6, lane = tid & 63, l32 = lane & 31, h = lane >> 5;
    LAS unsigned char* lds = lds_in;
    for (int i = tid; i < 128 * STS / 4; i += 512) ((LAS unsigned*)(lds + S_ST))[i] = 0u;
    f32x16 st[2]; st[0] = zero16(); st[1] = zero16();
    f32x4 nwr[4];
#pragma unroll
    for (int i = 0; i < 4; ++i) nwr[i] = *(const f32x4*)(p.dn_norm_w + 16 * (tid & 7) + 4 * i);
    const int mtk = wid >> 1, ntv0 = 2 * (wid & 1);
    const int mt = wid >> 2, nt = wid & 3;
    DnRegs nx;
    dn_fetch(nx, p, b, hh, 0, tid);
    dn_fill(nx, lds, tid);
    u32x4 zc0 = nx.z0, zc1 = nx.z1;
    __syncthreads();
    for (int n = 0; n < 32; ++n) {
        lds = olds(lds_in);
        LAS const float* gcs = (LAS const float*)(lds + S_MISC);
        if (n < 31) dn_fetch(nx, p, b, hh, n + 1, tid);
        const float glast = gcs[63];
        f32x16 vn = zero16();
        f32x16 oa = zero16();
        {
            LAS const unsigned char* Ab = lds + S_WS + (32 * mt + l32) * 272 + 16 * h;
            LAS const unsigned char* Aq = lds + S_QS + (32 * mt + l32) * 272 + 16 * h;
            LAS const unsigned char* Bb = lds + S_ST + (32 * nt + l32) * STS + 16 * h;
#pragma unroll
            for (int ks = 0; ks < 8; ++ks) { const bf16x8 bfr = lds_b128(Bb + 32 * ks); vn = mfma32(lds_b128(Ab + 32 * ks), bfr, vn); oa = mfma32(lds_b128(Aq + 32 * ks), bfr, oa); }
            LAS const unsigned char* up = lds + S_US + (32 * mt + 4 * h) * 272 + (32 * nt + l32) * 2;
#pragma unroll
            for (int r = 0; r < 16; ++r) { const int ro = 8 * (r >> 2) + (r & 3); vn[r] = bf2f(*(LAS const bf16_t*)(up + ro * 272)) - vn[r]; }
        }
        __syncthreads();
        {
            const int ib = 32 * mt + 4 * h;
            LAS const float* gci = gcs + ib;
            LAS unsigned char* w1p = lds + S_US + (32 * nt + l32) * VTS + ib * 2; LAS unsigned char* w2p = lds + S_WS + (32 * nt + l32) * VTS + ib * 2;
#pragma unroll
            for (int ig = 0; ig < 4; ++ig) {
                const float e0 = fexp(glast - gci[8 * ig]), e1 = fexp(glast - gci[8 * ig + 1]), e2 = fexp(glast - gci[8 * ig + 2]), e3 = fexp(glast - gci[8 * ig + 3]);
                u32x2 w = {pk2(vn[4 * ig], vn[4 * ig + 1]), pk2(vn[4 * ig + 2], vn[4 * ig + 3])};
                u32x2 ws = {pk2(vn[4 * ig] * e0, vn[4 * ig + 1] * e1), pk2(vn[4 * ig + 2] * e2, vn[4 * ig + 3] * e3)};
                *(LAS u32x2*)(w1p + 16 * ig) = w; *(LAS u32x2*)(w2p + 16 * ig) = ws;
            }
        }
        __syncthreads();
        {
            { LAS const float* gci = gcs + 32 * mt + 4 * h;
#pragma unroll
              for (int r = 0; r < 16; ++r) oa[r] *= fexp(gci[8 * (r >> 2) + (r & 3)]); }
            LAS const unsigned char* A2 = lds + S_AT + (32 * mt + l32) * ATS + 16 * h;
            LAS const unsigned char* B2 = lds + S_US + (32 * nt + l32) * VTS + 16 * h;
#pragma unroll
            for (int ks = 0; ks < 4; ++ks) oa = mfma32(lds_b128(A2 + 32 * ks), lds_b128(B2 + 32 * ks), oa);
            const float eg = fexp(glast);
            st[0] = st[0] * eg; st[1] = st[1] * eg;
            LAS const unsigned char* kp = lds + S_KS + (8 * h + ((lane & 15) >> 2)) * 272 + (32 * mtk + 16 * ((lane >> 4) & 1) + 4 * (lane & 3)) * 2;
#pragma unroll
            for (int s = 0; s < 4; ++s) {
                const bf16x8 af = cat8(tr_read(kp + (16 * s) * 272), tr_read(kp + (16 * s + 4) * 272));
#pragma unroll
                for (int q = 0; q < 2; ++q) {
                    const bf16x8 bfr = lds_b128(lds + S_WS + (32 * (ntv0 + q) + l32) * VTS + (16 * s + 8 * h) * 2);
                    st[q] = mfma32(af, bfr, st[q]);
                }
            }
        }
        __syncthreads();
        {
            { LAS unsigned char* osw = lds + S_OS + (32 * mt + 4 * h) * 272 + (32 * nt + l32) * 2;
#pragma unroll
              for (int r = 0; r < 16; ++r) *(LAS bf16_t*)(osw + (8 * (r >> 2) + (r & 3)) * 272) = f2bf(oa[r]); }
#pragma unroll
            for (int q = 0; q < 2; ++q) { LAS unsigned char* sp = lds + S_ST + (32 * (ntv0 + q) + l32) * STS + (32 * mtk + 4 * h) * 2;
#pragma unroll
                for (int ig = 0; ig < 4; ++ig) {
                    u32x2 w = {pk2(st[q][4 * ig], st[q][4 * ig + 1]), pk2(st[q][4 * ig + 2], st[q][4 * ig + 3])};
                    *(LAS u32x2*)(sp + 16 * ig) = w; } }
            if (n < 31) dn_fill(nx, lds, tid);
        }
        __syncthreads();
        {
            const int r = tid >> 3, cc = tid & 7; const size_t grow = (size_t)b * SEQ + 64 * n + r;
            const u32x4 oa4 = *(LAS const u32x4*)(lds + S_OS + r * 272 + cc * 32), ob4 = *(LAS const u32x4*)(lds + S_OS + r * 272 + cc * 32 + 16);
            float y[16] = {bflo(oa4[0]), bfhi(oa4[0]), bflo(oa4[1]), bfhi(oa4[1]), bflo(oa4[2]), bfhi(oa4[2]), bflo(oa4[3]), bfhi(oa4[3]),
                           bflo(ob4[0]), bfhi(ob4[0]), bflo(ob4[1]), bfhi(ob4[1]), bflo(ob4[2]), bfhi(ob4[2]), bflo(ob4[3]), bfhi(ob4[3])};
            float ss = 0.f;
#pragma unroll
            for (int i = 0; i < 16; ++i) ss += y[i] * y[i];
            ss = sum8(ss);
            const float rs = rsqrtf(ss * (1.0f / 128.0f) + EPS);
            const float z[16] = {bflo(zc0[0]), bfhi(zc0[0]), bflo(zc0[1]), bfhi(zc0[1]), bflo(zc0[2]), bfhi(zc0[2]), bflo(zc0[3]), bfhi(zc0[3]),
                                 bflo(zc1[0]), bfhi(zc1[0]), bflo(zc1[1]), bfhi(zc1[1]), bflo(zc1[2]), bfhi(zc1[2]), bflo(zc1[3]), bfhi(zc1[3])};
#pragma unroll
            for (int i = 0; i < 16; ++i) y[i] = y[i] * rs * nwr[i >> 2][i & 3] * siluf_(z[i]);
            u32x4 wa = {pk2(y[0], y[1]), pk2(y[2], y[3]), pk2(y[4], y[5]), pk2(y[6], y[7])}, wb = {pk2(y[8], y[9]), pk2(y[10], y[11]), pk2(y[12], y[13]), pk2(y[14], y[15])};
            bf16_t* op = p.odn + grow * 1024 + hh * 128 + 16 * cc;
            *(u32x4*)op = wa; *(u32x4*)(op + 8) = wb;
            zc0 = nx.z0; zc1 = nx.z1;
        }
    }
    __syncthreads();
}

__device__ void phase_mixers(const Params& p, LAS unsigned char* lds) {
    LAS int* slot = (LAS int*)(lds + L_Q);
    for (;;) {
        __syncthreads();
        if (threadIdx.x == 0) *slot = (int)atomicAdd(p.ctr, 1u);
        __syncthreads();
        const int item = *slot;
        if (item >= 64 + 512 + 264) break;
        if (item < 64) dn_scan(p, item >> 3, item & 7, lds);
        else if (item < 576) { const int e = item - 64; const int qb = 31 - (e >> 4); nsa_item(p, (e >> 1) & 7, e & 1, qb, lds); }
        else {
            const int f = item - 576;
            if (f < 176) transpose_tiles<2, 256>(p.w_ffn_gate, p.w_ffn_up, DM, DFF, p.Wt_gu, NGU_P, (LAS float*)lds, f * 8, 1, f * 8 + 8, p.norm2_w);
            else transpose_tiles<0, 256>(p.w_ffn_down, nullptr, DFF, DM, p.Wt_dn, DM, (LAS float*)lds, (f - 176) * 8, 1, (f - 176) * 8 + 8);
        }
    }
}


#define XB_TMO      128
#define XB_XCNT(j)  (256  + 64 * (j))
#define XB_XSUB(j)  (1280 + 64 * (j))
#define XB_XGEN(j)  (2304 + 64 * (j))
#define XB_TOP      3328
#define XB_TOPGEN   3392
#define XCD_BAR_WORDS 3456
#define XB_SPIN_CAP (1u << 18)
DI unsigned xb_ld(unsigned* p)              { return __hip_atomic_load(p, __ATOMIC_RELAXED, __HIP_MEMORY_SCOPE_AGENT); }
DI unsigned xb_add(unsigned* p, unsigned v) { return __hip_atomic_fetch_add(p, v, __ATOMIC_RELAXED, __HIP_MEMORY_SCOPE_AGENT); }
DI unsigned xb_xcc_id() { return (unsigned)__builtin_amdgcn_s_getreg((3 << 11) | 20) & 0xFu; }
#define XB_SPIN(cond, bar) do { unsigned _sp = 0; while (cond) { __builtin_amdgcn_s_sleep(1); \
    if ((++_sp & 255u) == 0u) { if (xb_ld(&(bar)[XB_TMO])) break; if (_sp > XB_SPIN_CAP) { atomicAdd(&(bar)[XB_TMO], 1u); break; } } } } while (0)
struct XcdBarrier { unsigned* bar; unsigned x; volatile LAS unsigned* st; };
DI XcdBarrier xcd_barrier_post(unsigned* bar, volatile LAS unsigned* st) {
    XcdBarrier b; b.bar = bar; b.x = xb_xcc_id(); b.st = st;
    if (threadIdx.x == 0) (void)xb_add(&bar[XB_XCNT(b.x)], 1u);
    return b;
}
DI void xcd_barrier_complete(unsigned* bar, unsigned x, unsigned& nloc, unsigned& nx) {
    const unsigned G = gridDim.x * gridDim.y * gridDim.z;
    unsigned sum, cnt, mine, sp = 0u;
    for (;;) {
        sum = 0u; cnt = 0u; mine = 0u;
#pragma unroll
        for (unsigned j = 0; j < 16; ++j) { const unsigned c = xb_ld(&bar[XB_XCNT(j)]); sum += c; cnt += (c > 0u) ? 1u : 0u; mine = (j == x) ? c : mine; }
        if (sum == G) break;
        __builtin_amdgcn_s_sleep(1);
        if ((++sp & 255u) == 0u) { if (xb_ld(&bar[XB_TMO])) break; if (sp > XB_SPIN_CAP) { atomicAdd(&bar[XB_TMO], 1u); break; } }
    }
    nloc = mine > 0u ? mine : 1u; nx = cnt > 0u ? cnt : 1u;
}
DI void xcd_barrier_leader(unsigned* bar, unsigned x, volatile LAS unsigned* st) {
    __builtin_amdgcn_s_waitcnt(0);
    unsigned nloc = st[0], nx = st[1];
    if (nloc == 0u) { xcd_barrier_complete(bar, x, nloc, nx); st[0] = nloc; st[1] = nx; }
    const unsigned old = xb_add(&bar[XB_XSUB(x)], 1u);
    const unsigned gen = old / nloc;
    if (old + 1u == (gen + 1u) * nloc) {
        __builtin_amdgcn_fence(__ATOMIC_RELEASE, "agent");
        asm volatile("s_waitcnt vmcnt(0)" ::: "memory");
        const unsigned og = xb_add(&bar[XB_TOP], 1u);
        const unsigned tg = og / nx;
        if (og + 1u == (tg + 1u) * nx) xb_add(&bar[XB_TOPGEN], 1u);
        else XB_SPIN(xb_ld(&bar[XB_TOPGEN]) == tg, bar);
        __builtin_amdgcn_fence(__ATOMIC_ACQUIRE, "agent");
        xb_add(&bar[XB_XGEN(x)], 1u);
        asm volatile("s_waitcnt vmcnt(0)" ::: "memory");
    } else {
        XB_SPIN(xb_ld(&bar[XB_XGEN(x)]) == gen, bar);
        __builtin_amdgcn_fence(__ATOMIC_ACQUIRE, "agent");
        asm volatile("s_waitcnt vmcnt(0)" ::: "memory");
    }
}
DI void xcd_barrier(const XcdBarrier& b) {
    asm volatile("s_waitcnt vmcnt(0)" ::: "memory");
    __syncthreads();
    if (threadIdx.x == 0) xcd_barrier_leader(b.bar, b.x, b.st);
    __syncthreads();
}

__global__ __launch_bounds__(512, 2) void hybrid_block_megakernel(Params p) {
    extern __shared__ __attribute__((aligned(16))) unsigned char shm[];
    LAS unsigned char* lds = (LAS unsigned char*)shm;
    cg::grid_group grid = cg::this_grid();
    const int G = gridDim.x, c = blockIdx.x;
    __shared__ uint4 xb_words;
    if (threadIdx.x == 0) xb_words = make_uint4(0u, 0u, 0u, 0u);
    if (blockIdx.x == 0) { for (int i = threadIdx.x; i < XCD_BAR_WORDS; i += 512) p.bar[i] = 0u; }
    phase_prep(p, lds);
    grid.sync();
    const XcdBarrier xbar = xcd_barrier_post(p.bar, (volatile LAS unsigned*)&xb_words);
    { pg8::Gemm g{p.h, p.Wt_in, T_TOK, NIN_P, DM}; pg8::StaticOrder S; S.init(g.M, g.N, G, c);
      EpiInProj E{p.qbuf, p.kvbuf, p.dnqkv, p.dnz, p.mg, p.small, p.rcos, p.rsin}; pg8::gemm_phase(lds, g, S, E); }
    xcd_barrier(xbar);
    phase_compress(p, lds);
    { LAS int* slot = (LAS int*)(lds + L_Q);
      __syncthreads();
      if (threadIdx.x == 0) *slot = (int)atomicAdd(p.ctr + 1, 1u);
      __syncthreads();
      int item = *slot;
      PrepRegs R;
      if (item < 2048) dn_prep_issue(p, item, R, otid());
      while (item < 2048) item = dn_prep_item(p, item, R, lds);
    }
    xcd_barrier(xbar);
    phase_mixers(p, lds);
    xcd_barrier(xbar);
    { pg8::Gemm g{p.onsa, p.Wt_upn, T_TOK, DM, 1024}; pg8::StaticOrder S; S.init(g.M, g.N, G, c); EpiUp<0> E{p.mixed, p.mg, 0}; pg8::gemm_phase(lds, g, S, E); }
    { pg8::Gemm g{p.odn, p.Wt_upd, T_TOK, DM, 1024}; pg8::StaticOrder S; S.init(g.M, g.N, G, c); EpiUp<1> E{p.mixed, p.mg, 2048}; pg8::gemm_phase(lds, g, S, E); }
    xcd_barrier(xbar);
    { pg8::Gemm g{p.mixed, p.Wt_o, T_TOK, DM, DM}; pg8::StaticOrder S; S.init(g.M, g.N, G, c); EpiWo E{p.out, p.x, p.h, p.rowss}; pg8::gemm_phase(lds, g, S, E); }
    xcd_barrier(xbar);
    { pg8::Gemm g{p.h, p.Wt_gu, T_TOK, NGU_P, DM}; pg8::StaticOrder S; S.init(g.M, g.N, G, c); EpiGU E{p.act, p.rowss}; pg8::gemm_phase(lds, g, S, E); }
    xcd_barrier(xbar);
    { pg8::Gemm g{p.act, p.Wt_dn, T_TOK, DM, DFF}; pg8::StaticOrder S; S.init(g.M, g.N, G, c); EpiResF32<1> E{p.out, nullptr}; pg8::gemm_phase(lds, g, S, E); }
    xcd_barrier(xbar);
    rmsnorm_rows(p.out, p.norm_f_w, nullptr, p.out, T_TOK);
}

extern "C" void kernel_launch(void* const* d_in, const int* in_sizes, int n_in, void* d_out, int out_size, void* d_ws, size_t ws_size, hipStream_t stream) {
    constexpr size_t kDynLds = 131072;
    static int grid_blocks = 0;
    if (!grid_blocks) {
        int dev = 0, cus = 0, per_cu = 0;
        hipGetDevice(&dev);
        hipDeviceGetAttribute(&cus, hipDeviceAttributeMultiprocessorCount, dev);
        hipFuncSetAttribute((const void*)hybrid_block_megakernel, hipFuncAttributeMaxDynamicSharedMemorySize, (int)kDynLds);
        hipOccupancyMaxActiveBlocksPerMultiprocessor(&per_cu, hybrid_block_megakernel, 512, kDynLds);
        if (per_cu < 1) per_cu = 1;
        grid_blocks = cus * 1;
        if (grid_blocks > cus * per_cu) grid_blocks = cus * per_cu;
    }
    Params p{};
    const float* const* in = (const float* const*)d_in;
    p.x = in[0]; p.norm1_w = in[1]; p.w_in = in[2]; p.conv_w = in[3]; p.a_log = in[4]; p.dt_bias = in[5]; p.dn_norm_w = in[6];
    p.cmp_pe_k = in[7]; p.cmp_w1_k = in[8]; p.cmp_w2_k = in[9]; p.cmp_pe_v = in[10]; p.cmp_w1_v = in[11]; p.cmp_w2_v = in[12];
    p.w_up_nsa = in[13]; p.w_up_dn = in[14]; p.w_o = in[15]; p.norm2_w = in[16]; p.w_ffn_gate = in[17]; p.w_ffn_up = in[18]; p.w_ffn_down = in[19]; p.norm_f_w = in[20];
    p.out = (float*)d_out;
    unsigned char* w = (unsigned char*)d_ws; size_t off = 0;
    auto take = [&](size_t bytes) { unsigned char* r = w + off; off += (bytes + 255) & ~(size_t)255; return r; };
    p.ctr = (unsigned*)take(256); p.bar = (unsigned*)take(XCD_BAR_WORDS * 4);
    p.dn_q = (bf16_t*)take((size_t)T_TOK * 1024 * 2); p.dn_k = (bf16_t*)take((size_t)T_TOK * 1024 * 2);
    p.Wt_o = (bf16_t*)take((size_t)DM * DM * 2); p.Wt_upn = (bf16_t*)take((size_t)DM * 1024 * 2); p.Wt_upd = (bf16_t*)take((size_t)DM * 1024 * 2);
    p.W1t_k = (bf16_t*)take((size_t)128 * 4096 * 2); p.W1t_v = (bf16_t*)take((size_t)128 * 4096 * 2); p.W2t_k = (bf16_t*)take(128 * 128 * 2); p.W2t_v = (bf16_t*)take(128 * 128 * 2);
    p.rcos = (float*)take((size_t)SEQ * 64 * 4); p.rsin = (float*)take((size_t)SEQ * 64 * 4);
    p.kc = (bf16_t*)take((size_t)16 * 128 * 128 * 2); p.vc = (bf16_t*)take((size_t)16 * 128 * 128 * 2);
    p.small = (float*)take((size_t)T_TOK * 64 * 4); p.rowss = (float*)take((size_t)T_TOK * 4);
    p.h = (bf16_t*)take((size_t)T_TOK * DM * 2);
    p.onsa = p.h; p.odn = p.h + (size_t)T_TOK * 1024;
    p.qbuf = (bf16_t*)take((size_t)T_TOK * 1024 * 2); p.kvbuf = (bf16_t*)take((size_t)T_TOK * 1536 * 2);
    p.mixed = p.qbuf;
    p.dnqkv = (bf16_t*)take((size_t)T_TOK * 3072 * 2); p.dnz = (bf16_t*)take((size_t)T_TOK * 1024 * 2); p.onsa_f32 = (float*)take((size_t)T_TOK * 1024 * 4);
    p.Wt_gu = p.dnqkv; p.Wt_dn = p.Wt_gu + (size_t)NGU_P * DM;
    p.mg = (bf16_t*)d_out;
    p.Wt_in = (bf16_t*)take((size_t)NIN_P * DM * 2 + 39321600);
    p.act = p.dnz;
    p.dn_u = p.Wt_in; p.dn_w = p.dn_u + (size_t)T_TOK * 1024; p.dn_at = p.dn_w + (size_t)T_TOK * 1024; p.dn_gc = (float*)(p.dn_at + (size_t)2048 * 4096);
    if (off > ws_size) { fprintf(stderr, "workspace too small: need %zu have %zu\n", off, ws_size); return; }
    void* args[] = {&p};
    hipError_t e = hipLaunchCooperativeKernel((void*)hybrid_block_megakernel, dim3(grid_blocks), dim3(512), args, kDynLds, stream);
    if (e != hipSuccess) fprintf(stderr, "cooperative launch failed: %s (grid %d)\n", hipGetErrorString(e), grid_blocks);
}
```

```cpp
#include <hip/hip_runtime.h>
#include <hip/hip_cooperative_groups.h>
#include <cstdio>
namespace cg = cooperative_groups;

#define LAS __attribute__((address_space(3)))
#define DI __device__ __forceinline__
typedef unsigned short bf16_t;
typedef short bf16x8 __attribute__((ext_vector_type(8)));
typedef short s16x4 __attribute__((ext_vector_type(4)));
typedef float f32x2 __attribute__((ext_vector_type(2)));
typedef float f32x4 __attribute__((ext_vector_type(4)));
typedef float f32x16 __attribute__((ext_vector_type(16)));
typedef unsigned u32x2 __attribute__((ext_vector_type(2)));
typedef unsigned u32x4 __attribute__((ext_vector_type(4)));
typedef __bf16 bfv2 __attribute__((ext_vector_type(2)));

constexpr int T_TOK = 16384, SEQ = 2048, DM = 2048, DFF = 5632;
constexpr int NIN_P = 11008, NGU_P = 11264;
constexpr float EPS = 1e-6f;

DI unsigned pk2(float a, float b) { f32x2 v = {a, b}; bfv2 r = __builtin_convertvector(v, bfv2); return __builtin_bit_cast(unsigned, r); }
DI float bf2f(bf16_t b) { return __uint_as_float(((unsigned)b) << 16); }
DI float bflo(unsigned u) { return __uint_as_float(u << 16); }
DI float bfhi(unsigned u) { return __uint_as_float(u & 0xffff0000u); }
DI bf16_t f2bf(float f) { return (bf16_t)(pk2(f, 0.f) & 0xffffu); }
DI float fexp2(float x) { return __builtin_amdgcn_exp2f(x); }
DI float fexp(float x) { return __builtin_amdgcn_exp2f(x * 1.4426950408889634f); }
DI float frcp(float x) { return __builtin_amdgcn_rcpf(x); }
DI float sigmoidf_(float x) { return frcp(1.f + fexp(-x)); }
DI float siluf_(float x) { return x * sigmoidf_(x); }
DI f32x16 mfma32(bf16x8 a, bf16x8 b, f32x16 c) { return __builtin_amdgcn_mfma_f32_32x32x16_bf16(a, b, c, 0, 0, 0); }
DI s16x4 tr_read(LAS const unsigned char* p) { return __builtin_amdgcn_ds_read_tr16_b64_v4i16((LAS s16x4*)p); }
DI bf16x8 cat8(s16x4 a, s16x4 b) { return __builtin_shufflevector(a, b, 0, 1, 2, 3, 4, 5, 6, 7); }
DI bf16x8 lds_b128(LAS const unsigned char* p) { return *(LAS const bf16x8*)p; }
DI LAS unsigned char* olds(LAS unsigned char* l) { unsigned z = 0; asm volatile("" : "+v"(z)); return l + z; }
DI int otid() { int t = threadIdx.x; asm volatile("" : "+v"(t)); return t; }
DI float xor32_sum(float v) { const unsigned u = __float_as_uint(v); auto r = __builtin_amdgcn_permlane32_swap(u, u, false, false); return __uint_as_float(r[0]) + __uint_as_float(r[1]); }
#define DPP_F(v, ctrl) __uint_as_float(__builtin_amdgcn_update_dpp(0u, __float_as_uint(v), (ctrl), 0xF, 0xF, true))
DI float sum8(float v) { v += DPP_F(v, 0xB1); v += DPP_F(v, 0x4E); v += DPP_F(v, 0x141); return v; }
DI f32x16 zero16() { f32x16 z; for (int i = 0; i < 16; ++i) z[i] = 0.f; return z; }

struct Params {
    const float *x, *norm1_w, *w_in, *conv_w, *a_log, *dt_bias, *dn_norm_w, *cmp_pe_k, *cmp_w1_k, *cmp_w2_k, *cmp_pe_v, *cmp_w1_v, *cmp_w2_v,
        *w_up_nsa, *w_up_dn, *w_o, *norm2_w, *w_ffn_gate, *w_ffn_up, *w_ffn_down, *norm_f_w;
    float* out;
    bf16_t *Wt_in, *Wt_gu, *Wt_dn, *Wt_o, *Wt_upn, *Wt_upd, *W1t_k, *W1t_v, *W2t_k, *W2t_v;
    bf16_t *h, *qbuf, *kvbuf, *dnqkv, *dnz, *mg, *onsa, *odn, *mixed, *act, *kc, *vc;
    float *small, *rcos, *rsin, *onsa_f32, *dn_gc, *rowss;
    bf16_t *dn_q, *dn_k, *dn_u, *dn_w, *dn_at;
    unsigned* ctr; unsigned* bar;
};

namespace pg8 {
constexpr int BM = 256, BK = 64, HALF = 128, HTB = HALF * BK * 2, STAGE_BYTES = 8 * HTB, NXCD = 8, WGM = 8;
DI int lds_byte(int r, int c) { const int st = (r >> 4) * 2 + (c >> 5), rr = r & 15, cc = c & 31, ob = rr * 64 + cc * 2; return st * 1024 + (ob ^ (((ob >> 9) & 1) << 5)); }
DI void stage_rc(int b, int& R, int& C) { const int st = b / 1024, sb = b % 1024, swz = sb ^ (((sb >> 9) & 1) << 5); R = (st >> 1) * 16 + swz / 64; C = (st & 1) * 32 + (swz % 64) / 2; }
DI int perm32(int rho) { const int n = rho >> 4, i = rho & 15; return 8 * (i >> 2) + 4 * n + (i & 3); }
struct Unit { int pm, pn; };
struct Gemm { const bf16_t* A; const bf16_t* Bt; int M, N, K; };
struct StaticOrder {
    int nM, nN, nwg, G, c;
    DI void init(int M, int N, int G_, int c_) { nM = M / BM; nN = N / BM; nwg = nM * nN; G = G_; c = c_; }
    DI bool next(int i, Unit& u) const {
        const long L = (long)i * G + c; if (L >= nwg) return false;
        int wgid = (int)L; { const int q = nwg / NXCD, r = nwg % NXCD, xcd = wgid % NXCD, off = wgid / NXCD; wgid = (xcd < r ? xcd * (q + 1) : r * (q + 1) + (xcd - r) * q) + off; }
        const int nig = WGM * nN, gid = wgid / nig, fm = gid * WGM, gsz = (nM - fm) < WGM ? (nM - fm) : WGM;
        u.pm = fm + ((wgid % nig) % gsz); u.pn = (wgid % nig) / gsz; return true;
    }
};

template <class Epi>
DI void gemm_phase(LAS unsigned char* lds, const Gemm g, const StaticOrder& S, const Epi& E) {
    const int tid = otid(), wid = __builtin_amdgcn_readfirstlane(tid >> 6), lane = tid & 63, wr = wid >> 2, wc = wid & 3, fr = lane & 15, fq = lane >> 4;
    const int K = g.K, nt = K / BK;
    unsigned voffA[2], voffB[2];
#pragma unroll
    for (int i = 0; i < 2; ++i) { int R, C; stage_rc(tid * 16 + i * 8192, R, C); const int Rb = Epi::PERM ? ((R & ~31) + perm32(R & 31)) : R;
        voffA[i] = (unsigned)(R * K + C) * 2u; voffB[i] = (unsigned)(Rb * K + C) * 2u; }
    const size_t kstep = (size_t)(BK * 2);
    const size_t hstep = (size_t)HALF * K * 2;
    const size_t tstep = 2 * hstep;
    const unsigned ldsw = (unsigned)wid * 1024u;
    const int aoff = lds_byte(wr * 64 + fr, fq * 8), boff = lds_byte(wc * 32 + fr, fq * 8);
#define PG8_SA(b, h) (((b) * 2 + (h)) * HTB)
#define PG8_SB(b, h) ((4 + (b) * 2 + (h)) * HTB)
#define PG8_STAGE(bufoff, gbase, voff) do { _Pragma("unroll") for (int _i = 0; _i < 2; ++_i) \
        __builtin_amdgcn_global_load_lds((const unsigned*)((const char*)(gbase) + (voff)[_i]), (LAS unsigned*)(lds + (bufoff) + ldsw + _i * 8192), 16, 0, 0); } while (0)
#define PG8_LDA(dst, b, h) do { _Pragma("unroll") for (int m = 0; m < 4; ++m) _Pragma("unroll") for (int k = 0; k < 2; ++k) dst[m][k] = *(const LAS bf16x8*)(lds + PG8_SA(b, h) + aoff + m * 2048 + k * 1024); } while (0)
#define PG8_LDB(dst, b, h) do { _Pragma("unroll") for (int n = 0; n < 2; ++n) _Pragma("unroll") for (int k = 0; k < 2; ++k) dst[n][k] = *(const LAS bf16x8*)(lds + PG8_SB(b, h) + boff + n * 2048 + k * 1024); } while (0)
#define PG8_MMA(ai, bj, At, Bt) do { __builtin_amdgcn_s_setprio(1); _Pragma("unroll") for (int m = 0; m < 4; ++m) _Pragma("unroll") for (int n = 0; n < 2; ++n) _Pragma("unroll") for (int k = 0; k < 2; ++k) \
        acc[ai][bj][m][n] = __builtin_amdgcn_mfma_f32_16x16x32_bf16(Bt[n][k], At[m][k], acc[ai][bj][m][n], 0, 0, 0); __builtin_amdgcn_s_setprio(0); } while (0)
#define PG8_WAIT_V(n) asm volatile("s_waitcnt vmcnt(" #n ")" ::: "memory")
#define PG8_WAIT_L(n) asm volatile("s_waitcnt lgkmcnt(" #n ")" ::: "memory")
#define PG8_BAR __builtin_amdgcn_s_barrier()
#define PG8_SCHED __builtin_amdgcn_sched_barrier(0)
    Unit cur, nxt; int ui = 0;
    if (!S.next(0, cur)) return;
    f32x4 acc[2][2][4][2];
#pragma unroll
    for (int a = 0; a < 2; ++a)
#pragma unroll
        for (int b = 0; b < 2; ++b)
#pragma unroll
            for (int m = 0; m < 4; ++m)
#pragma unroll
                for (int n = 0; n < 2; ++n) acc[a][b][m][n] = (f32x4){0.f, 0.f, 0.f, 0.f};
    bf16x8 At[4][2], B0[2][2], B1[2][2];
    const char* cA = (const char*)g.A + (size_t)cur.pm * tstep; const char* cB = (const char*)g.Bt + (size_t)cur.pn * tstep;
    PG8_STAGE(PG8_SB(0, 0), cB, voffB); PG8_STAGE(PG8_SA(0, 0), cA, voffA); PG8_STAGE(PG8_SB(0, 1), cB + hstep, voffB); PG8_STAGE(PG8_SA(0, 1), cA + hstep, voffA);
    if (wr == 1) PG8_BAR;
    PG8_WAIT_V(4); PG8_BAR;
    PG8_STAGE(PG8_SB(1, 0), cB + kstep, voffB); PG8_STAGE(PG8_SA(1, 0), cA + kstep, voffA); PG8_STAGE(PG8_SB(1, 1), cB + hstep + kstep, voffB);
    PG8_WAIT_V(6); PG8_BAR;
    for (;;) {
        const bool has_next = S.next(ui + 1, nxt);
        const char* nA = has_next ? (const char*)g.A + (size_t)nxt.pm * tstep : cA; const char* nB = has_next ? (const char*)g.Bt + (size_t)nxt.pn * tstep : cB;
        for (int t = 0; t < nt; t += 2) {
            const bool last = (t == nt - 2);
            const char* a1 = cA + (size_t)(t + 1) * kstep;
            const char* a2 = last ? nA : cA + (size_t)(t + 2) * kstep; const char* b2 = last ? nB : cB + (size_t)(t + 2) * kstep;
            const char* a3 = a2 + kstep; const char* b3 = b2 + kstep;
            PG8_LDB(B0, 0, 0); PG8_SCHED; PG8_LDA(At, 0, 0); PG8_STAGE(PG8_SA(1, 1), a1 + hstep, voffA);
            PG8_WAIT_L(8); PG8_BAR; PG8_WAIT_L(0); PG8_MMA(0, 0, At, B0); PG8_BAR; PG8_SCHED;
            PG8_LDB(B1, 0, 1); PG8_STAGE(PG8_SB(0, 0), b2, voffB);
            PG8_BAR; PG8_WAIT_L(0); PG8_MMA(0, 1, At, B1); PG8_BAR;
            PG8_LDA(At, 0, 1); PG8_STAGE(PG8_SA(0, 0), a2, voffA);
            PG8_BAR; PG8_WAIT_L(0); PG8_MMA(1, 0, At, B0); PG8_BAR; PG8_SCHED;
            PG8_STAGE(PG8_SB(0, 1), b2 + hstep, voffB);
            PG8_WAIT_V(6); PG8_BAR; PG8_MMA(1, 1, At, B1); PG8_BAR;
            PG8_LDB(B0, 1, 0); PG8_SCHED; PG8_LDA(At, 1, 0); PG8_STAGE(PG8_SA(0, 1), a2 + hstep, voffA);
            PG8_WAIT_L(8); PG8_BAR; PG8_WAIT_L(0); PG8_MMA(0, 0, At, B0); PG8_BAR; PG8_SCHED;
            PG8_LDB(B1, 1, 1); PG8_STAGE(PG8_SB(1, 0), b3, voffB);
            PG8_BAR; PG8_WAIT_L(0); PG8_MMA(0, 1, At, B1); PG8_BAR;
            PG8_LDA(At, 1, 1); PG8_STAGE(PG8_SA(1, 0), a3, voffA);
            PG8_BAR; PG8_WAIT_L(0); PG8_MMA(1, 0, At, B0); PG8_BAR; PG8_SCHED;
            PG8_STAGE(PG8_SB(1, 1), b3 + hstep, voffB);
            PG8_WAIT_V(6); PG8_BAR; PG8_MMA(1, 1, At, B1); PG8_BAR;
        }
        E(acc, cur, wr, wc, fr, fq);
        if (!has_next) break;
#pragma unroll
        for (int a = 0; a < 2; ++a)
#pragma unroll
            for (int b = 0; b < 2; ++b)
#pragma unroll
                for (int m = 0; m < 4; ++m)
#pragma unroll
                    for (int n = 0; n < 2; ++n) acc[a][b][m][n] = (f32x4){0.f, 0.f, 0.f, 0.f};
        cur = nxt; cA = nA; cB = nB; ++ui;
    }
    PG8_WAIT_V(0);
    if (wr == 0) PG8_BAR;
    PG8_BAR;
#undef PG8_SA
#undef PG8_SB
#undef PG8_STAGE
#undef PG8_LDA
#undef PG8_LDB
#undef PG8_MMA
#undef PG8_WAIT_V
#undef PG8_WAIT_L
#undef PG8_BAR
#undef PG8_SCHED
}
}
using pg8::Unit;

typedef f32x4 AccT[2][2][4][2];

struct EpiInProj {
    static constexpr bool PERM = true;
    bf16_t *qbuf, *kvbuf, *dnqkv, *dnz, *mg; float* small; const float *rcos, *rsin;
    DI void operator()(const AccT& acc, const Unit& u, int wr, int wc, int fr, int fq) const {
        const int pn = u.pn; const int row0 = u.pm * 256 + wr * 64 + fr; const int cl = wc * 32 + 8 * fq;
        if (pn == 42) {
            if (wc < 2) {
#pragma unroll
                for (int ai = 0; ai < 2; ++ai)
#pragma unroll
                    for (int m = 0; m < 4; ++m) { float* rp = small + (size_t)(row0 + ai * 128 + m * 16) * 64 + cl;
                        *(f32x4*)(rp) = acc[ai][0][m][0]; *(f32x4*)(rp + 4) = acc[ai][0][m][1]; }
            }
            return;
        }
        bf16_t* dst; int ld, cbase; bool rope = false;
        if (pn < 4) { dst = qbuf; ld = 1024; cbase = pn * 256; rope = true; }
        else if (pn < 10) { dst = kvbuf; ld = 1536; cbase = (pn - 4) * 256; rope = ((pn - 4) & 1) == 0; }
        else if (pn < 22) { dst = dnqkv; ld = 3072; cbase = (pn - 10) * 256; }
        else if (pn < 26) { dst = dnz; ld = 1024; cbase = (pn - 22) * 256; }
        else { dst = mg; ld = 4096; cbase = (pn - 26) * 256; }
        if (rope) {
            const int i4 = 4 * (4 * wc + fq);
            f32x4 invr;
#pragma unroll
            for (int e = 0; e < 4; ++e) invr[e] = fexp2(-(float)(2 * (i4 + e)) * (13.287712379549449f / 128.0f)) * 0.15915494309189535f;
#pragma unroll
            for (int ai = 0; ai < 2; ++ai)
#pragma unroll
                for (int m = 0; m < 4; ++m) {
                    const int row = row0 + ai * 128 + m * 16; const int t = row & (SEQ - 1);
                    f32x4 c, s;
#pragma unroll
                    for (int e = 0; e < 4; ++e) { float rev = (float)t * invr[e]; rev = rev - floorf(rev); c[e] = __builtin_amdgcn_cosf(rev); s[e] = __builtin_amdgcn_sinf(rev); }
#pragma unroll
                    for (int bj = 0; bj < 2; ++bj) {
                        const f32x4 x1 = acc[ai][bj][m][0], x2 = acc[ai][bj][m][1];
                        const f32x4 o1 = x1 * c - x2 * s, o2 = x2 * c + x1 * s;
                        bf16_t* rp = dst + (size_t)row * ld + cbase + bj * 128 + i4;
                        u32x2 w1 = {pk2(o1[0], o1[1]), pk2(o1[2], o1[3])}, w2 = {pk2(o2[0], o2[1]), pk2(o2[2], o2[3])};
                        *(u32x2*)rp = w1; *(u32x2*)(rp + 64) = w2;
                    }
                }
        } else {
#pragma unroll
            for (int ai = 0; ai < 2; ++ai)
#pragma unroll
                for (int m = 0; m < 4; ++m) {
                    bf16_t* rp = dst + (size_t)(row0 + ai * 128 + m * 16) * ld + cbase + cl;
#pragma unroll
                    for (int bj = 0; bj < 2; ++bj) { const f32x4 v0 = acc[ai][bj][m][0], v1 = acc[ai][bj][m][1];
                        u32x4 w = {pk2(v0[0], v0[1]), pk2(v0[2], v0[3]), pk2(v1[0], v1[1]), pk2(v1[2], v1[3])};
                        *(u32x4*)(rp + bj * 128) = w; }
                }
        }
    }
};

template <int PASS> struct EpiUp {
    static constexpr bool PERM = true;
    bf16_t* mixed; const bf16_t* mg; int gofs;
    DI void operator()(const AccT& acc, const Unit& u, int wr, int wc, int fr, int fq) const {
        const int row0 = u.pm * 256 + wr * 64 + fr; const int col0 = u.pn * 256 + wc * 32 + 8 * fq;
#pragma unroll
        for (int ai = 0; ai < 2; ++ai)
#pragma unroll
            for (int mh = 0; mh < 2; ++mh) {
                u32x4 gvv[2][2], pvv[2][2];
#pragma unroll
                for (int mm = 0; mm < 2; ++mm) { const size_t row = (size_t)(row0 + ai * 128 + (2 * mh + mm) * 16);
#pragma unroll
                    for (int bj = 0; bj < 2; ++bj) { const int col = col0 + bj * 128;
                        gvv[mm][bj] = *(const u32x4*)(mg + row * 4096 + gofs + col);
                        if (PASS == 1) pvv[mm][bj] = *(const u32x4*)(mixed + row * 2048 + col); } }
#pragma unroll
                for (int mm = 0; mm < 2; ++mm) { const size_t row = (size_t)(row0 + ai * 128 + (2 * mh + mm) * 16);
#pragma unroll
                    for (int bj = 0; bj < 2; ++bj) {
                        const int col = col0 + bj * 128; const u32x4 gv = gvv[mm][bj];
                        bf16_t* op = mixed + row * 2048 + col;
                        const f32x4 v0 = acc[ai][bj][2 * mh + mm][0], v1 = acc[ai][bj][2 * mh + mm][1];
                        float r[8];
                        r[0] = sigmoidf_(bflo(gv[0])) * v0[0]; r[1] = sigmoidf_(bfhi(gv[0])) * v0[1]; r[2] = sigmoidf_(bflo(gv[1])) * v0[2]; r[3] = sigmoidf_(bfhi(gv[1])) * v0[3];
                        r[4] = sigmoidf_(bflo(gv[2])) * v1[0]; r[5] = sigmoidf_(bfhi(gv[2])) * v1[1]; r[6] = sigmoidf_(bflo(gv[3])) * v1[2]; r[7] = sigmoidf_(bfhi(gv[3])) * v1[3];
                        if (PASS == 1) { const u32x4 pv = pvv[mm][bj];
                            r[0] += bflo(pv[0]); r[1] += bfhi(pv[0]); r[2] += bflo(pv[1]); r[3] += bfhi(pv[1]); r[4] += bflo(pv[2]); r[5] += bfhi(pv[2]); r[6] += bflo(pv[3]); r[7] += bfhi(pv[3]); }
                        u32x4 w = {pk2(r[0], r[1]), pk2(r[2], r[3]), pk2(r[4], r[5]), pk2(r[6], r[7])};
                        *(u32x4*)op = w;
                    } }
            }
    }
};

template <int ACCUM> struct EpiResF32 {
    static constexpr bool PERM = false;
    float* out; const float* resid;
    DI void operator()(const AccT& acc, const Unit& u, int wr, int wc, int fr, int fq) const {
        const int row0 = u.pm * 256 + wr * 64 + fr, col0 = u.pn * 256 + wc * 32 + 4 * fq;
        const float* src = ACCUM ? (const float*)out : resid;
#pragma unroll
        for (int ai = 0; ai < 2; ++ai)
#pragma unroll
            for (int mh = 0; mh < 2; ++mh) {
                f32x4 base[2][2][2];
#pragma unroll
                for (int mm = 0; mm < 2; ++mm) { const size_t ro = (size_t)(row0 + ai * 128 + (2 * mh + mm) * 16) * DM + col0;
#pragma unroll
                    for (int bj = 0; bj < 2; ++bj)
#pragma unroll
                        for (int n = 0; n < 2; ++n) base[mm][bj][n] = *(const f32x4*)(src + ro + bj * 128 + n * 16); }
#pragma unroll
                for (int mm = 0; mm < 2; ++mm) { const size_t ro = (size_t)(row0 + ai * 128 + (2 * mh + mm) * 16) * DM + col0;
#pragma unroll
                    for (int bj = 0; bj < 2; ++bj)
#pragma unroll
                        for (int n = 0; n < 2; ++n) *(f32x4*)(out + ro + bj * 128 + n * 16) = base[mm][bj][n] + acc[ai][bj][2 * mh + mm][n]; }
            }
    }
};

struct EpiWo {
    static constexpr bool PERM = false;
    float* out; const float* resid; bf16_t* xb; float* rowss;
    DI void operator()(const AccT& acc, const Unit& u, int wr, int wc, int fr, int fq) const {
        const int row0 = u.pm * 256 + wr * 64 + fr, col0 = u.pn * 256 + wc * 32 + 4 * fq;
#pragma unroll
        for (int ai = 0; ai < 2; ++ai)
#pragma unroll
            for (int mh = 0; mh < 2; ++mh) {
                f32x4 base[2][2][2];
#pragma unroll
                for (int mm = 0; mm < 2; ++mm) { const size_t ro = (size_t)(row0 + ai * 128 + (2 * mh + mm) * 16) * DM + col0;
#pragma unroll
                    for (int bj = 0; bj < 2; ++bj)
#pragma unroll
                        for (int n = 0; n < 2; ++n) base[mm][bj][n] = *(const f32x4*)(resid + ro + bj * 128 + n * 16); }
#pragma unroll
                for (int mm = 0; mm < 2; ++mm) { const int row = row0 + ai * 128 + (2 * mh + mm) * 16; const size_t ro = (size_t)row * DM + col0;
                    float ss = 0.f;
#pragma unroll
                    for (int bj = 0; bj < 2; ++bj)
#pragma unroll
                        for (int n = 0; n < 2; ++n) { const f32x4 v = base[mm][bj][n] + acc[ai][bj][2 * mh + mm][n];
                            *(f32x4*)(out + ro + bj * 128 + n * 16) = v;
                            u32x2 w = {pk2(v[0], v[1]), pk2(v[2], v[3])}; *(u32x2*)(xb + ro + bj * 128 + n * 16) = w;
                            ss += v[0] * v[0] + v[1] * v[1] + v[2] * v[2] + v[3] * v[3]; }
                    ss += __shfl_xor(ss, 16); ss += __shfl_xor(ss, 32);
                    if (fq == 0) atomicAdd(rowss + row, ss);
                }
            }
    }
};

struct EpiGU {
    static constexpr bool PERM = true;
    bf16_t* act; const float* rowss;
    DI void operator()(const AccT& acc, const Unit& u, int wr, int wc, int fr, int fq) const {
        const int row0 = u.pm * 256 + wr * 64 + fr; const int col0 = (u.pn * 256 + wc * 32 + 8 * fq) >> 1;
        float rs[2][4];
#pragma unroll
        for (int ai = 0; ai < 2; ++ai)
#pragma unroll
            for (int m = 0; m < 4; ++m) rs[ai][m] = rowss[row0 + ai * 128 + m * 16];
#pragma unroll
        for (int ai = 0; ai < 2; ++ai)
#pragma unroll
            for (int m = 0; m < 4; ++m) rs[ai][m] = rsqrtf(rs[ai][m] * (1.0f / DM) + EPS);
#pragma unroll
        for (int ai = 0; ai < 2; ++ai)
#pragma unroll
            for (int m = 0; m < 4; ++m) { bf16_t* rp = act + (size_t)(row0 + ai * 128 + m * 16) * DFF + col0; const float r = rs[ai][m];
#pragma unroll
                for (int bj = 0; bj < 2; ++bj) { const f32x4 gt = acc[ai][bj][m][0] * r, up = acc[ai][bj][m][1] * r;
                    u32x2 w = {pk2(siluf_(gt[0]) * up[0], siluf_(gt[1]) * up[1]), pk2(siluf_(gt[2]) * up[2], siluf_(gt[3]) * up[3])};
                    *(u32x2*)(rp + bj * 64) = w; } }
    }
};

DI float wave_sum(float v) {
#pragma unroll
    for (int o = 32; o >= 1; o >>= 1) v += __shfl_xor(v, o);
    return v;
}

__device__ void rmsnorm_rows(const float* __restrict__ x, const float* __restrict__ w, bf16_t* outb, float* outf, int nrows) {
    const int tid_ = otid(); const int lane = tid_ & 63; const int gw = blockIdx.x * 8 + (tid_ >> 6), nw = gridDim.x * 8;
    for (int row = gw; row < nrows; row += nw) {
        const f32x4* xr = (const f32x4*)(x + (size_t)row * DM);
        f32x4 v[8]; float ss = 0.f;
#pragma unroll
        for (int i = 0; i < 8; ++i) { v[i] = xr[lane + 64 * i]; ss += v[i][0] * v[i][0] + v[i][1] * v[i][1] + v[i][2] * v[i][2] + v[i][3] * v[i][3]; }
        ss = wave_sum(ss);
        const float r = rsqrtf(ss * (1.0f / DM) + EPS);
#pragma unroll
        for (int i = 0; i < 8; ++i) { const f32x4 wv = ((const f32x4*)w)[lane + 64 * i]; const f32x4 o = v[i] * r * wv;
            if (outb) { u32x2 pw = {pk2(o[0], o[1]), pk2(o[2], o[3])}; *(u32x2*)(outb + (size_t)row * DM + 4 * (lane + 64 * i)) = pw; }
            else { *(f32x4*)(outf + (size_t)row * DM + 4 * (lane + 64 * i)) = o; } }
    }
}

DI int rope_perm(int r) { const int i = r >> 3, j = r & 7; return j < 4 ? 4 * i + j : 64 + 4 * i + (j - 4); }
DI int src_in(int p) {
    if (p < 1024) return (p & ~127) + rope_perm(p & 127);
    if (p < 2560) { const int pp = p - 1024; const int grp = pp >> 8; if (!(grp & 1)) return 1024 + (pp & ~127) + rope_perm(pp & 127); return 1024 + pp; }
    if (p < 5632) return 2584 + (p - 2560);
    if (p < 6656) return 5656 + (p - 5632);
    if (p < 10752) return 6696 + (p - 6656);
    const int s = p - 10752;
    if (s < 24) return 2560 + s;
    if (s < 32) return 6680 + (s - 24);
    if (s < 40) return 6688 + (s - 32);
    return -1;
}

template <int MODE, int PW>
__device__ void transpose_tiles(const float* __restrict__ W, const float* __restrict__ W2, int K, int N, bf16_t* Wt, int Np, LAS float* tile, int t0, int tstep, int tend, const float* __restrict__ kscale = nullptr) {
    const int tid = otid(); const int nkt = K / 64;
    constexpr int PQ = PW / 4, KR = 512 / PQ;
    for (int tt = t0; tt < tend; tt += tstep) {
        const int pt = tt / nkt, kt = tt % nkt; const int p0 = pt * PW, k0 = kt * 64;
        { const int pl = (tid % PQ) * 4, kr = tid / PQ; const int p = p0 + pl; const float* src = W; int sc;
          if (MODE == 0) sc = p; else if (MODE == 1) sc = src_in(p); else { const int g8 = p >> 3, j = p & 7; sc = 4 * g8 + (j & 3); if (j >= 4) src = W2; }
          const float* sp = src + (size_t)(k0 + kr) * N + (sc >= 0 ? sc : 0);
          f32x4 v[64 / KR];
#pragma unroll
          for (int i = 0; i < 64 / KR; ++i) v[i] = *(const f32x4*)(sp + (size_t)(i * KR) * N);
#pragma unroll
          for (int i = 0; i < 64 / KR; ++i) { LAS float* tp = tile + (kr + i * KR) * (PW + 1) + pl; const bool ok = sc >= 0;
              const float ks = kscale ? kscale[k0 + kr + i * KR] : 1.f;
              tp[0] = ok ? v[i][0] * ks : 0.f; tp[1] = ok ? v[i][1] * ks : 0.f; tp[2] = ok ? v[i][2] * ks : 0.f; tp[3] = ok ? v[i][3] * ks : 0.f; } }
        __syncthreads();
        { const int kq = tid & 7, pr = tid >> 3;
#pragma unroll
          for (int ps = 0; ps < PW / 64; ++ps) { float v[8]; const int prr = pr + 64 * ps;
#pragma unroll
              for (int i = 0; i < 8; ++i) v[i] = tile[(8 * kq + i) * (PW + 1) + prr];
              u32x4 w = {pk2(v[0], v[1]), pk2(v[2], v[3]), pk2(v[4], v[5]), pk2(v[6], v[7])};
              *(u32x4*)(Wt + (size_t)(p0 + prr) * K + k0 + 8 * kq) = w; } }
        __syncthreads();
    }
}
template <int MODE, int PW>
__device__ void transpose_w(const float* __restrict__ W, const float* __restrict__ W2, int K, int N, bf16_t* Wt, int Np, LAS float* tile, int& tcount) {
    const int ntile = (K / 64) * (Np / PW);
    transpose_tiles<MODE, PW>(W, W2, K, N, Wt, Np, tile, ((int)blockIdx.x - tcount % (int)gridDim.x + (int)gridDim.x) % (int)gridDim.x, (int)gridDim.x, ntile);
    tcount += ntile;
}

__device__ void phase_prep(const Params& p, LAS unsigned char* lds) {
    if (blockIdx.x == 0 && threadIdx.x == 0) { p.ctr[0] = 0u; p.ctr[1] = 0u; }
    for (int i = blockIdx.x * 512 + threadIdx.x; i < T_TOK; i += gridDim.x * 512) p.rowss[i] = 0.f;
    rmsnorm_rows(p.x, p.norm1_w, p.h, nullptr, T_TOK);
    LAS float* tile = (LAS float*)lds; int tc = 0;
    transpose_w<1, 256>(p.w_in, nullptr, DM, 10792, p.Wt_in, NIN_P, tile, tc);
    transpose_w<0, 256>(p.w_o, nullptr, DM, DM, p.Wt_o, DM, tile, tc);
    transpose_w<0, 256>(p.w_up_nsa, nullptr, 1024, DM, p.Wt_upn, DM, tile, tc);
    transpose_w<0, 256>(p.w_up_dn, nullptr, 1024, DM, p.Wt_upd, DM, tile, tc);
    transpose_w<0, 128>(p.cmp_w1_k, nullptr, 4096, 128, p.W1t_k, 128, tile, tc);
    transpose_w<0, 128>(p.cmp_w1_v, nullptr, 4096, 128, p.W1t_v, 128, tile, tc);
    transpose_w<0, 128>(p.cmp_w2_k, nullptr, 128, 128, p.W2t_k, 128, tile, tc);
    transpose_w<0, 128>(p.cmp_w2_v, nullptr, 128, 128, p.W2t_v, 128, tile, tc);
}

DI float gelu_tanh(float x) { const float u = 0.7978845608028654f * (x + 0.044715f * x * x * x); const float e = fexp(2.f * u); return 0.5f * x * (2.f - 2.f * frcp(e + 1.f)); }

__device__ void phase_compress(const Params& p, LAS unsigned char* lds) {
    const int tid = otid(), wid = tid >> 6, lane = tid & 63, l32 = lane & 31, h = lane >> 5;
    const int kq = wid & 3, nh = wid >> 2;
    LAS float* red = (LAS float*)lds;
    LAS unsigned char* Hs = lds + 4 * 32 * 132 * 4;
    for (int item = blockIdx.x; item < 128; item += gridDim.x) {
        const int mt = item & 3, hk = (item >> 2) & 1, b = (item >> 3) & 7, kv = item >> 6;
        const bf16_t* W1t = kv ? p.W1t_v : p.W1t_k; const bf16_t* W2t = kv ? p.W2t_v : p.W2t_k; const float* pe = kv ? p.cmp_pe_v : p.cmp_pe_k;
        bf16_t* outp = (kv ? p.vc : p.kc) + (size_t)((b * 2 + hk) * 128) * 128;
        const int c = 32 * mt + l32;
        const bf16_t* abase = p.kvbuf + (size_t)(b * SEQ) * 1536 + kv * 256 + hk * 128 + 32 * kq + 8 * h;
        f32x16 acc[2]; acc[0] = zero16(); acc[1] = zero16();
#pragma unroll 4
        for (int li = 0; li < 32; ++li) {
            int tok = 16 * c + li; tok = tok > SEQ - 1 ? SEQ - 1 : tok;
#pragma unroll
            for (int s2 = 0; s2 < 2; ++s2) {
                const u32x4 av = *(const u32x4*)(abase + (size_t)tok * 1536 + 16 * s2);
                const f32x4 pe0 = *(const f32x4*)(pe + li * 128 + 32 * kq + 16 * s2 + 8 * h), pe1 = *(const f32x4*)(pe + li * 128 + 32 * kq + 16 * s2 + 8 * h + 4);
                u32x4 aw = {pk2(bflo(av[0]) + pe0[0], bfhi(av[0]) + pe0[1]), pk2(bflo(av[1]) + pe0[2], bfhi(av[1]) + pe0[3]),
                            pk2(bflo(av[2]) + pe1[0], bfhi(av[2]) + pe1[1]), pk2(bflo(av[3]) + pe1[2], bfhi(av[3]) + pe1[3])};
                const bf16x8 af = __builtin_bit_cast(bf16x8, aw);
#pragma unroll
                for (int n2 = 0; n2 < 2; ++n2) {
                    const bf16x8 bfr = *(const bf16x8*)(W1t + (size_t)(64 * nh + 32 * n2 + l32) * 4096 + li * 128 + 32 * kq + 16 * s2 + 8 * h);
                    acc[n2] = mfma32(af, bfr, acc[n2]);
                }
            }
        }
#pragma unroll
        for (int n2 = 0; n2 < 2; ++n2)
#pragma unroll
            for (int r = 0; r < 16; ++r) red[(kq * 32 + 8 * (r >> 2) + 4 * h + (r & 3)) * 132 + 64 * nh + 32 * n2 + l32] = acc[n2][r];
        __syncthreads();
        { const int row = tid >> 4, c8 = (tid & 15) * 8; float v[8];
#pragma unroll
          for (int i = 0; i < 8; ++i) { const int o = row * 132 + c8 + i; v[i] = gelu_tanh(red[o] + red[32 * 132 + o] + red[2 * 32 * 132 + o] + red[3 * 32 * 132 + o]); }
          u32x4 w = {pk2(v[0], v[1]), pk2(v[2], v[3]), pk2(v[4], v[5]), pk2(v[6], v[7])};
          *(LAS u32x4*)(Hs + row * 272 + c8 * 2) = w; }
        __syncthreads();
        if (wid < 4) {
            f32x16 o = zero16();
#pragma unroll
            for (int ks = 0; ks < 8; ++ks) {
                const bf16x8 af = lds_b128(Hs + l32 * 272 + (16 * ks + 8 * h) * 2);
                const bf16x8 bfr = *(const bf16x8*)(W2t + (size_t)(32 * wid + l32) * 128 + 16 * ks + 8 * h);
                o = mfma32(af, bfr, o);
            }
#pragma unroll
            for (int r = 0; r < 16; ++r) outp[(size_t)(32 * mt + 8 * (r >> 2) + 4 * h + (r & 3)) * 128 + 32 * wid + l32] = f2bf(o[r]);
        }
        __syncthreads();
    }
}

constexpr int KS = 272, VS = 320;
constexpr int L_K0 = 0, L_K1 = 17408, L_V0 = 34816, L_V1 = 55296, L_PART = 75776, L_MASK = 109568, L_Q = 131056;
constexpr float SC_LOG2E = 0.08838834764831845f * 1.4426950408889634f;

struct KVRegs { u32x4 k0, k1, v0, v1; };
DI void kv_load(KVRegs& r, const bf16_t* Kg, const bf16_t* Vg, int ld, int j, int tid) {
    const int r0 = tid >> 4, c16 = tid & 15;
    const size_t o0 = (size_t)(64 * j + r0) * ld + 8 * c16, o1 = o0 + (size_t)32 * ld;
    r.k0 = *(const u32x4*)(Kg + o0); r.k1 = *(const u32x4*)(Kg + o1); r.v0 = *(const u32x4*)(Vg + o0); r.v1 = *(const u32x4*)(Vg + o1);
}
DI void kv_store(const KVRegs& r, LAS unsigned char* Kl, LAS unsigned char* Vl, int tid) {
    const int r0 = tid >> 4, c16 = tid & 15;
    *(LAS u32x4*)(Kl + r0 * KS + 16 * c16) = r.k0; *(LAS u32x4*)(Kl + (r0 + 32) * KS + 16 * c16) = r.k1;
    *(LAS u32x4*)(Vl + r0 * VS + 16 * c16) = r.v0; *(LAS u32x4*)(Vl + (r0 + 32) * VS + 16 * c16) = r.v1;
}
DI void qk_block(LAS const unsigned char* Kl, const bf16x8 (&qf)[8], int lane, f32x16& s0, f32x16& s1) {
    const int l32 = lane & 31, h = lane >> 5;
    s0 = zero16(); s1 = zero16();
    LAS const unsigned char* kp = Kl + l32 * KS + 16 * h;
    bf16x8 A[2][4];
    A[0][0] = lds_b128(kp); A[0][1] = lds_b128(kp + 32 * KS); A[0][2] = lds_b128(kp + 32); A[0][3] = lds_b128(kp + 32 * KS + 32);
#pragma unroll
    for (int b = 0; b < 4; ++b) {
        if (b < 3) { A[(b + 1) & 1][0] = lds_b128(kp + 64 * (b + 1)); A[(b + 1) & 1][1] = lds_b128(kp + 32 * KS + 64 * (b + 1));
                     A[(b + 1) & 1][2] = lds_b128(kp + 64 * (b + 1) + 32); A[(b + 1) & 1][3] = lds_b128(kp + 32 * KS + 64 * (b + 1) + 32); }
        s0 = mfma32(A[b & 1][0], qf[2 * b], s0); s1 = mfma32(A[b & 1][1], qf[2 * b], s1);
        s0 = mfma32(A[b & 1][2], qf[2 * b + 1], s0); s1 = mfma32(A[b & 1][3], qf[2 * b + 1], s1);
    }
}
DI bf16x8 pack8(const f32x16& p, int q) {
    u32x4 w = {pk2(p[8 * q], p[8 * q + 1]), pk2(p[8 * q + 2], p[8 * q + 3]), pk2(p[8 * q + 4], p[8 * q + 5]), pk2(p[8 * q + 6], p[8 * q + 7])};
    return __builtin_bit_cast(bf16x8, w);
}
DI void pv_block(LAS const unsigned char* Vl, const bf16x8 (&pb)[4], int lane, f32x16 (&o)[4]) {
    const int h = lane >> 5;
    LAS const unsigned char* vp = Vl + (4 * h + ((lane & 15) >> 2)) * VS + (16 * ((lane >> 4) & 1) + 4 * (lane & 3)) * 2;
    s16x4 V[2][8];
#pragma unroll
    for (int dt = 0; dt < 4; ++dt) { V[0][2 * dt] = tr_read(vp + 64 * dt); V[0][2 * dt + 1] = tr_read(vp + 8 * VS + 64 * dt); }
#pragma unroll
    for (int kq = 0; kq < 4; ++kq) {
        if (kq < 3) {
#pragma unroll
            for (int dt = 0; dt < 4; ++dt) { V[(kq + 1) & 1][2 * dt] = tr_read(vp + (16 * (kq + 1)) * VS + 64 * dt); V[(kq + 1) & 1][2 * dt + 1] = tr_read(vp + (16 * (kq + 1) + 8) * VS + 64 * dt); }
        }
#pragma unroll
        for (int dt = 0; dt < 4; ++dt) o[dt] = mfma32(cat8(V[kq & 1][2 * dt], V[kq & 1][2 * dt + 1]), pb[kq], o[dt]);
    }
}
DI void softmax_block(f32x16& s0, f32x16& s1, int lo, int hi, int h, float& m, float& l, f32x16 (&o)[4], bf16x8 (&pb)[4]) {
    float mx = -1e30f;
    if (__any((lo > 0) || (hi < 63))) {
        const int lo2 = lo - 4 * h, hi2 = hi - 4 * h;
#pragma unroll
        for (int i = 0; i < 16; ++i) { const int k0 = 8 * (i >> 2) + (i & 3);
            s0[i] = (k0 >= lo2 && k0 <= hi2) ? s0[i] : -1e30f; s1[i] = (k0 + 32 >= lo2 && k0 + 32 <= hi2) ? s1[i] : -1e30f; }
    }
#pragma unroll
    for (int i = 0; i < 16; ++i) mx = fmaxf(mx, fmaxf(s0[i], s1[i]));
    mx = fmaxf(mx, __shfl_xor(mx, 32));
    const float mn = fmaxf(m, mx);
    const float alpha = fexp2((m - mn) * SC_LOG2E);
    const float mb = mn * SC_LOG2E;
    m = mn;
    float ps = 0.f;
#pragma unroll
    for (int i = 0; i < 16; ++i) { s0[i] = fexp2(s0[i] * SC_LOG2E - mb); s1[i] = fexp2(s1[i] * SC_LOG2E - mb); ps += s0[i] + s1[i]; }
    l = l * alpha + ps;
    if (__any(alpha != 1.0f)) {
#pragma unroll
        for (int dt = 0; dt < 4; ++dt) o[dt] = o[dt] * alpha;
    }
    pb[0] = pack8(s0, 0); pb[1] = pack8(s0, 1); pb[2] = pack8(s1, 0); pb[3] = pack8(s1, 1);
}

template <int MODE>
DI void branch_out(const f32x16 (&o)[4], float fac, float* of32, bf16_t* obf, int h) {
#pragma unroll
    for (int dt = 0; dt < 4; ++dt)
#pragma unroll
        for (int ig = 0; ig < 4; ++ig) {
            const int d0 = 32 * dt + 8 * ig + 4 * h;
            f32x4 v = {o[dt][4 * ig] * fac, o[dt][4 * ig + 1] * fac, o[dt][4 * ig + 2] * fac, o[dt][4 * ig + 3] * fac};
            if (MODE >= 1) v += *(const f32x4*)(of32 + d0);
            if (MODE <= 1) *(f32x4*)(of32 + d0) = v;
            if (MODE == 2) { u32x2 w = {pk2(v[0], v[1]), pk2(v[2], v[3])}; *(u32x2*)(obf + d0) = w; }
        }
}

template <int MODE>
DI void attn_stream(const bf16_t* Kg, const bf16_t* Vg, int jlo, int jhi, unsigned blockmask, unsigned mymask, int qb, int tl,
                    const bf16x8 (&qf)[8], f32x16 (&o)[4], float& m, float& l, LAS unsigned char* lds, int tid, int lane) {
    const int h = lane >> 5;
    int j = jlo;
    if (MODE == 1) { while (j <= jhi && !((blockmask >> j) & 1u)) ++j; }
    KVRegs kr;
    kv_load(kr, Kg, Vg, 1536, j, tid);
    kv_store(kr, lds + L_K0, lds + L_V0, tid);
    __syncthreads();
    int cur = 0;
    for (;;) {
        int jn = j + 1;
        if (MODE == 1) { while (jn <= jhi && !((blockmask >> jn) & 1u)) ++jn; }
        const bool hn = jn <= jhi;
        if (hn) kv_load(kr, Kg, Vg, 1536, jn, tid);
        LAS unsigned char* Kl = lds + (cur ? L_K1 : L_K0); LAS unsigned char* Vl = lds + (cur ? L_V1 : L_V0);
        f32x16 s0, s1; qk_block(Kl, qf, lane, s0, s1);
        int lo = 0, hi = 63;
        if (MODE == 1) { if (j == qb) hi = tl; if (!((mymask >> j) & 1u)) hi = -1; }
        else { if (j == qb - 8) lo = tl + 1; if (j == qb) hi = tl; }
        bf16x8 pb[4];
        softmax_block(s0, s1, lo, hi, h, m, l, o, pb);
        pv_block(Vl, pb, lane, o);
        if (!hn) break;
        kv_store(kr, lds + (cur ? L_K0 : L_K1), lds + (cur ? L_V0 : L_V1), tid);
        __syncthreads();
        cur ^= 1; j = jn;
    }
    __syncthreads();
}

__device__ void nsa_item(const Params& p, int b, int hk, int qb, LAS unsigned char* lds) {
    const int tid = otid(), wid = tid >> 6, lane = tid & 63, l32 = lane & 31, h = lane >> 5;
    const int g = wid >> 1, tl = (wid & 1) * 32 + l32, t = qb * 64 + tl; const size_t row = (size_t)b * SEQ + t; const int head = hk * 4 + g;
    bf16x8 qf[8];
    { const bf16_t* qp = p.qbuf + row * 1024 + head * 128 + 8 * h;
#pragma unroll
      for (int ks = 0; ks < 8; ++ks) qf[ks] = *(const bf16x8*)(qp + 16 * ks); }
    const float* glp = p.small + row * 64 + head * 3;
    const float gate0 = sigmoidf_(glp[0]), gate1 = sigmoidf_(glp[1]), gate2 = sigmoidf_(glp[2]);
    float* of32 = p.onsa_f32 + row * 1024 + head * 128; bf16_t* obf = p.onsa + row * 1024 + head * 128;
    f32x16 o[4];
    const int ncb = (qb >= 16) ? 2 : 1;
    {
        const bf16_t* kcg = p.kc + (size_t)((b * 2 + hk) * 128) * 128; const bf16_t* vcg = p.vc + (size_t)((b * 2 + hk) * 128) * 128;
        KVRegs kr;
        kv_load(kr, kcg, vcg, 128, 0, tid); kv_store(kr, lds + L_K0, lds + L_V0, tid);
        if (ncb == 2) { kv_load(kr, kcg, vcg, 128, 1, tid); kv_store(kr, lds + L_K1, lds + L_V1, tid); }
        __syncthreads();
        const int cmax = (t >= 31) ? min(126, (t - 31) >> 4) : -1;
        f32x16 s[4];
        qk_block(lds + L_K0, qf, lane, s[0], s[1]);
        if (ncb == 2) qk_block(lds + L_K1, qf, lane, s[2], s[3]); else { s[2] = zero16(); s[3] = zero16(); }
        float mx = -1e20f;
#pragma unroll
        for (int q = 0; q < 4; ++q)
#pragma unroll
            for (int i = 0; i < 16; ++i) { const int c = 32 * q + 8 * (i >> 2) + 4 * h + (i & 3); s[q][i] = (c <= cmax) ? s[q][i] : -1e30f; mx = fmaxf(mx, s[q][i]); }
        mx = fmaxf(mx, __shfl_xor(mx, 32));
        float ps = 0.f;
#pragma unroll
        for (int q = 0; q < 4; ++q)
#pragma unroll
            for (int i = 0; i < 16; ++i) { s[q][i] = fexp2((s[q][i] - mx) * SC_LOG2E); ps += s[q][i]; }
        ps += __shfl_xor(ps, 32);
        const float inv = ps > 0.f ? frcp(ps) : 0.f;
        if (ncb == 2) {
            LAS float* part = (LAS float*)(lds + L_PART) + (g * 64 + tl) * 33;
#pragma unroll
            for (int q = 0; q < 4; ++q)
#pragma unroll
                for (int ig = 0; ig < 4; ++ig) part[8 * q + 2 * ig + h] = (s[q][4 * ig] + s[q][4 * ig + 1] + s[q][4 * ig + 2] + 0.5f * s[q][4 * ig + 3]) * inv;
            __syncthreads();
#pragma unroll
            for (int q = 0; q < 4; ++q)
#pragma unroll
                for (int ig = 0; ig < 4; ++ig) { const int jj = 8 * q + 2 * ig + h + 1; if (jj < 32) part[jj] += 0.5f * s[q][4 * ig + 3] * inv; }
        }
#pragma unroll
        for (int dt = 0; dt < 4; ++dt) o[dt] = zero16();
        { bf16x8 pb[4]; pb[0] = pack8(s[0], 0); pb[1] = pack8(s[0], 1); pb[2] = pack8(s[1], 0); pb[3] = pack8(s[1], 1); pv_block(lds + L_V0, pb, lane, o); }
        if (ncb == 2) { bf16x8 pb[4]; pb[0] = pack8(s[2], 0); pb[1] = pack8(s[2], 1); pb[2] = pack8(s[3], 0); pb[3] = pack8(s[3], 1); pv_block(lds + L_V1, pb, lane, o); }
        branch_out<0>(o, gate0 * inv, of32, obf, h);
        __syncthreads();
    }
    unsigned mymask, blockmask;
    if (qb >= 16) {
        LAS unsigned* masks = (LAS unsigned*)(lds + L_MASK);
        {
            const int ttl = tid >> 3, jq = tid & 7;
            LAS const float* pp = (LAS const float*)(lds + L_PART) + ttl * 33;
            float imp[32];
#pragma unroll
            for (int j = 0; j < 32; ++j) { float v = pp[j] + pp[64 * 33 + j] + pp[2 * 64 * 33 + j] + pp[3 * 64 * 33 + j];
                if (j == 0 || j == qb || j == qb - 1) v = 1e9f; else if (j > qb) v = -1e9f;
                imp[j] = v; }
            unsigned bits = 0u;
#pragma unroll
            for (int q = 0; q < 4; ++q) {
                const int j = 4 * jq + q; float vj = 0.f;
#pragma unroll
                for (int jj = 0; jj < 32; ++jj) vj = (jj == j) ? imp[jj] : vj;
                int rank = 0;
#pragma unroll
                for (int jj = 0; jj < 32; ++jj) rank += (imp[jj] > vj || (imp[jj] == vj && jj < j)) ? 1 : 0;
                if (rank < 16) bits |= 1u << j;
            }
            bits |= __shfl_xor(bits, 1); bits |= __shfl_xor(bits, 2); bits |= __shfl_xor(bits, 4);
            if (jq == 0) masks[ttl] = bits;
        }
        __syncthreads();
        mymask = masks[tl]; blockmask = 0u;
        for (int i = 0; i < 64; ++i) blockmask |= masks[i];
    } else { mymask = (2u << qb) - 1u; blockmask = mymask; }
    {
        float m = -1e20f, l = 0.f;
#pragma unroll
        for (int dt = 0; dt < 4; ++dt) o[dt] = zero16();
        const bf16_t* Kg = p.kvbuf + (size_t)(b * SEQ) * 1536 + 2 * 256 + hk * 128; const bf16_t* Vg = Kg + 256;
        attn_stream<1>(Kg, Vg, 0, qb, blockmask, mymask, qb, tl, qf, o, m, l, lds, tid, lane);
        l += __shfl_xor(l, 32);
        branch_out<1>(o, gate1 * frcp(l), of32, obf, h);
    }
    {
        float m = -1e20f, l = 0.f;
#pragma unroll
        for (int dt = 0; dt < 4; ++dt) o[dt] = zero16();
        const bf16_t* Kg = p.kvbuf + (size_t)(b * SEQ) * 1536 + 4 * 256 + hk * 128; const bf16_t* Vg = Kg + 256;
        attn_stream<2>(Kg, Vg, max(0, qb - 8), qb, 0u, 0u, qb, tl, qf, o, m, l, lds, tid, lane);
        l += __shfl_xor(l, 32);
        branch_out<2>(o, gate2 * frcp(l), of32, obf, h);
    }
}

constexpr int D_QS = 0, D_KS = 17408, D_VS = 34816, D_WS = 52224, D_LS = 69632, D_AT = 87040, D_MISC = 130048;
constexpr int STS = 264, VTS = 136, ATS = 144;

struct PrepRegs { u32x4 xr[3][4][2]; float w4[4]; float sa, sb; };
DI void dn_prep_issue(const Params& p, int item, PrepRegs& R, int tid) {
    const int b = item & 7, hh = (item >> 3) & 7, n = item >> 6;
    const int r = tid >> 3, cc = tid & 7; const int tok = 64 * n + r; const size_t grow = (size_t)b * SEQ + tok;
#pragma unroll
    for (int seg = 0; seg < 3; ++seg)
#pragma unroll
        for (int tp = 0; tp < 4; ++tp) {
            const int tk = tok - 3 + tp; const size_t rr = tk >= 0 ? grow - 3 + tp : grow;
            const bf16_t* xp = p.dnqkv + rr * 3072 + seg * 1024 + hh * 128 + 16 * cc;
            R.xr[seg][tp][0] = *(const u32x4*)xp; R.xr[seg][tp][1] = *(const u32x4*)(xp + 8);
        }
    const int t384 = tid < 384 ? tid : 0;
#pragma unroll
    for (int tp = 0; tp < 4; ++tp) R.w4[tp] = p.conv_w[(size_t)tp * 3072 + (t384 >> 7) * 1024 + hh * 128 + (t384 & 127)];
    const int tt = tid >= 448 ? tid - 448 : 0; const size_t gr = (size_t)b * SEQ + 64 * n + tt;
    R.sa = p.small[gr * 64 + 24 + hh]; R.sb = p.small[gr * 64 + 32 + hh];
}
__device__ int dn_prep_item(const Params& p, int item, PrepRegs& R, LAS unsigned char* lds_in) {
    const int b = item & 7, hh = (item >> 3) & 7, n = item >> 6; int next_item;
    const int tid = otid(), wid = tid >> 6, lane = tid & 63, l32 = lane & 31, h = lane >> 5;
    LAS unsigned char* lds = olds(lds_in);
    LAS float* gcs = (LAS float*)(lds + D_MISC); LAS float* betas = gcs + 64; LAS float* Ls = (LAS float*)olds(lds_in + D_LS);
    const float neg_ea = -__expf(p.a_log[hh]); const float dtb = p.dt_bias[hh];
    {
        {
            const int r = tid >> 3, cc = tid & 7; const int tok = 64 * n + r;
            LAS int* slot = (LAS int*)(lds + L_Q);
            if (tid == 0) *slot = (int)atomicAdd(p.ctr + 1, 1u);
            LAS float* wl = (LAS float*)(lds + D_WS);
            if (tid < 384) {
#pragma unroll
                for (int tp = 0; tp < 4; ++tp) wl[tp * 384 + tid] = R.w4[tp];
            }
            if (tid >= 448) {
                const int tt = tid - 448;
                const float a = R.sa + dtb, bl = R.sb;
                const float sp = a > 20.f ? a : log1pf(__expf(a));
                float gsum = neg_ea * sp;
#pragma unroll
                for (int o = 1; o < 64; o <<= 1) { const float u = __shfl_up(gsum, o); if (lane >= o) gsum += u; }
                gcs[tt] = gsum; betas[tt] = sigmoidf_(bl);
            }
            __syncthreads();
            next_item = *slot;
#pragma unroll
            for (int seg = 0; seg < 3; ++seg) {
                float y[16];
#pragma unroll
                for (int i = 0; i < 16; ++i) y[i] = 0.f;
#pragma unroll
                for (int tp = 0; tp < 4; ++tp) {
                    const float msk = (tok - 3 + tp >= 0) ? 1.f : 0.f;
                    const u32x4 xa = R.xr[seg][tp][0], xb = R.xr[seg][tp][1];
                    LAS const float* wp = wl + tp * 384 + seg * 128 + 16 * cc;
                    const f32x4 w0 = *(LAS const f32x4*)wp * msk, w1 = *(LAS const f32x4*)(wp + 4) * msk, w2 = *(LAS const f32x4*)(wp + 8) * msk, w3 = *(LAS const f32x4*)(wp + 12) * msk;
                    y[0] += bflo(xa[0]) * w0[0]; y[1] += bfhi(xa[0]) * w0[1]; y[2] += bflo(xa[1]) * w0[2]; y[3] += bfhi(xa[1]) * w0[3];
                    y[4] += bflo(xa[2]) * w1[0]; y[5] += bfhi(xa[2]) * w1[1]; y[6] += bflo(xa[3]) * w1[2]; y[7] += bfhi(xa[3]) * w1[3];
                    y[8] += bflo(xb[0]) * w2[0]; y[9] += bfhi(xb[0]) * w2[1]; y[10] += bflo(xb[1]) * w2[2]; y[11] += bfhi(xb[1]) * w2[3];
                    y[12] += bflo(xb[2]) * w3[0]; y[13] += bfhi(xb[2]) * w3[1]; y[14] += bflo(xb[3]) * w3[2]; y[15] += bfhi(xb[3]) * w3[3];
                }
                float ss = 0.f;
#pragma unroll
                for (int i = 0; i < 16; ++i) { y[i] = siluf_(y[i]); ss += y[i] * y[i]; }
                float sc = 1.f;
                if (seg < 2) { ss += __shfl_xor(ss, 1); ss += __shfl_xor(ss, 2); ss += __shfl_xor(ss, 4); sc = rsqrtf(ss + EPS); if (seg == 0) sc *= 0.08838834764831845f; }
                LAS unsigned char* dst = lds + (seg == 0 ? D_QS : (seg == 1 ? D_KS : D_VS)) + r * 272 + cc * 32;
                u32x4 wa = {pk2(y[0] * sc, y[1] * sc), pk2(y[2] * sc, y[3] * sc), pk2(y[4] * sc, y[5] * sc), pk2(y[6] * sc, y[7] * sc)};
                u32x4 wb = {pk2(y[8] * sc, y[9] * sc), pk2(y[10] * sc, y[11] * sc), pk2(y[12] * sc, y[13] * sc), pk2(y[14] * sc, y[15] * sc)};
                *(LAS u32x4*)dst = wa; *(LAS u32x4*)(dst + 16) = wb;
            }
            if (next_item < 2048) dn_prep_issue(p, next_item, R, tid);
        }
        __syncthreads();
        {
            const int isq = wid >> 2, bm = (wid >> 1) & 1, bn = wid & 1;
            LAS const unsigned char* Ab = lds + (isq ? D_QS : D_KS) + (32 * bm + l32) * 272 + 16 * h;
            LAS const unsigned char* Bb = lds + D_KS + (32 * bn + l32) * 272 + 16 * h;
            f32x16 acc = zero16();
            if (bm >= bn) {
#pragma unroll
                for (int ks = 0; ks < 8; ++ks) acc = mfma32(lds_b128(Ab + 32 * ks), lds_b128(Bb + 32 * ks), acc);
            }
            const int j = 32 * bn + l32; const float gj = gcs[j];
            const int ib = 32 * bm + 4 * h;
            LAS const float* gci = gcs + ib; LAS const float* bti = betas + ib;
            LAS unsigned char* atw = lds + D_AT + ib * ATS + j * 2; LAS float* lsw = Ls + ib * 68 + j;
#pragma unroll
            for (int r = 0; r < 16; ++r) {
                const int ro = 8 * (r >> 2) + (r & 3); const int i = ib + ro;
                const float dec = fexp(fminf(gci[ro] - gj, 0.f));
                if (isq) { const float v = (i >= j) ? acc[r] * dec : 0.f; *(LAS bf16_t*)(atw + ro * ATS) = f2bf(v); }
                else { const float v = (i > j) ? acc[r] * dec * bti[ro] : 0.f; lsw[ro * 68] = v; }
            }
        }
        __syncthreads();
        {
            const int c = 32 * wid + l32; const bool isw = wid >= 4;
            LAS const unsigned char* src = lds + (isw ? D_KS : D_VS) + (c & 127) * 2 + (4 * h) * 272;
            LAS const float* bth = betas + 4 * h; LAS const float* gch = gcs + 4 * h;
            float xs[32];
#pragma unroll
            for (int sidx = 0; sidx < 32; ++sidx) { const int ro = 8 * (sidx >> 2) + (sidx & 3);
                const float bi = bth[ro]; const float f = isw ? bi * fexp(gch[ro]) : bi; xs[sidx] = bf2f(*(LAS const bf16_t*)(src + ro * 272)) * f; }
            LAS const float* Lh = Ls + 4 * h;
#pragma unroll
            for (int i = 1; i < 64; ++i) {
                float a0 = 0.f, a1 = 0.f, a2 = 0.f, a3 = 0.f;
#pragma unroll
                for (int jj = 0; jj < (i + 7) / 8; ++jj) { const f32x4 lv = *(LAS const f32x4*)(Lh + i * 68 + 8 * jj);
                    a0 += lv[0] * xs[4 * jj]; a1 += lv[1] * xs[4 * jj + 1]; a2 += lv[2] * xs[4 * jj + 2]; a3 += lv[3] * xs[4 * jj + 3]; }
                const float tot = xor32_sum((a0 + a1) + (a2 + a3));
                const int g4 = i >> 2; const int slot = 4 * (g4 >> 1) + (i & 3);
                xs[slot] = (h == (g4 & 1)) ? xs[slot] - tot : xs[slot];
            }
            LAS unsigned char* dst = lds + (isw ? D_WS : D_VS) + (c & 127) * 2 + (4 * h) * 272;
#pragma unroll
            for (int sidx = 0; sidx < 32; ++sidx) { const int ro = 8 * (sidx >> 2) + (sidx & 3); *(LAS bf16_t*)(dst + ro * 272) = f2bf(xs[sidx]); }
        }
        __syncthreads();
        const size_t chunk = (size_t)((b * 8 + hh) * 32 + n);
        { const int r0 = tid >> 4, c16 = tid & 15;
#pragma unroll
          for (int rg = 0; rg < 4; ++rg) {
              const int lo = rg == 0 ? D_QS : (rg == 1 ? D_KS : (rg == 2 ? D_VS : D_WS));
              bf16_t* gb = (rg == 0 ? p.dn_q : (rg == 1 ? p.dn_k : (rg == 2 ? p.dn_u : p.dn_w))) + chunk * 8192;
#pragma unroll
              for (int hf = 0; hf < 2; ++hf) { const int r = r0 + 32 * hf; *(u32x4*)(gb + r * 128 + 8 * c16) = *(LAS const u32x4*)(lds + lo + r * 272 + 16 * c16); }
          }
          { const int r = tid >> 3, c8 = tid & 7; *(u32x4*)(p.dn_at + chunk * 4096 + r * 64 + 8 * c8) = *(LAS const u32x4*)(lds + D_AT + r * ATS + 16 * c8); }
          if (tid < 64) p.dn_gc[chunk * 64 + tid] = gcs[tid];
        }
    }
    __syncthreads();
    return next_item;
}

constexpr int S_WS = 0, S_QS = 17408, S_KS = 34816, S_US = 52224, S_AT = 69632, S_ST = 78848, S_MISC = 112640, S_OS = 112896, S_EXP = 130304;

struct DnRegs { u32x4 w0, w1, q0, q1, k0, k1, u0, u1, at, z0, z1; float gc; };
DI void dn_fetch(DnRegs& r, const Params& p, int b, int hh, int n, int tid) {
    const size_t chunk = (size_t)((b * 8 + hh) * 32 + n);
    const int r0 = tid >> 4, c16 = tid & 15; const size_t o0 = chunk * 8192 + r0 * 128 + 8 * c16, o1 = o0 + 32 * 128;
    r.w0 = *(const u32x4*)(p.dn_w + o0); r.w1 = *(const u32x4*)(p.dn_w + o1); r.q0 = *(const u32x4*)(p.dn_q + o0); r.q1 = *(const u32x4*)(p.dn_q + o1);
    r.k0 = *(const u32x4*)(p.dn_k + o0); r.k1 = *(const u32x4*)(p.dn_k + o1); r.u0 = *(const u32x4*)(p.dn_u + o0); r.u1 = *(const u32x4*)(p.dn_u + o1);
    r.at = *(const u32x4*)(p.dn_at + chunk * 4096 + (tid >> 3) * 64 + 8 * (tid & 7));
    r.gc = p.dn_gc[chunk * 64 + (tid & 63)];
    const bf16_t* zp = p.dnz + ((size_t)b * SEQ + 64 * n + (tid >> 3)) * 1024 + hh * 128 + 16 * (tid & 7);
    r.z0 = *(const u32x4*)zp; r.z1 = *(const u32x4*)(zp + 8);
}
DI void dn_fill(const DnRegs& r, LAS unsigned char* lds, int tid) {
    const int r0 = tid >> 4, c16 = tid & 15; const int a0 = r0 * 272 + 16 * c16, a1 = a0 + 32 * 272;
    *(LAS u32x4*)(lds + S_WS + a0) = r.w0; *(LAS u32x4*)(lds + S_WS + a1) = r.w1; *(LAS u32x4*)(lds + S_QS + a0) = r.q0; *(LAS u32x4*)(lds + S_QS + a1) = r.q1;
    *(LAS u32x4*)(lds + S_KS + a0) = r.k0; *(LAS u32x4*)(lds + S_KS + a1) = r.k1; *(LAS u32x4*)(lds + S_US + a0) = r.u0; *(LAS u32x4*)(lds + S_US + a1) = r.u1;
    *(LAS u32x4*)(lds + S_AT + (tid >> 3) * ATS + 16 * (tid & 7)) = r.at;
    if (tid < 64) ((LAS float*)(lds + S_MISC))[tid] = r.gc;
}

__device__ void dn_scan(const Params& p, int b, int hh, LAS unsigned char* lds_in) {
    const int tid = otid(), wid = tid >> 6, lane = tid & 63, l32 = lane & 31, h = lane >> 5;
    LAS unsigned char* lds = lds_in;
    for (int i = tid; i < 128 * STS / 4; i += 512) ((LAS unsigned*)(lds + S_ST))[i] = 0u;
    f32x16 st[2]; st[0] = zero16(); st[1] = zero16();
    f32x4 nwr[4];
#pragma unroll
    for (int i = 0; i < 4; ++i) nwr[i] = *(const f32x4*)(p.dn_norm_w + 16 * (tid & 7) + 4 * i);
    const int mtk = wid >> 1, ntv0 = 2 * (wid & 1);
    const int mt = wid >> 2, nt = wid & 3;
    DnRegs nx;
    dn_fetch(nx, p, b, hh, 0, tid);
    dn_fill(nx, lds, tid);
    u32x4 zc0 = nx.z0, zc1 = nx.z1;
    __syncthreads();
    for (int n = 0; n < 32; ++n) {
        lds = olds(lds_in);
        LAS const float* gcs = (LAS const float*)(lds + S_MISC);
        if (n < 31) dn_fetch(nx, p, b, hh, n + 1, tid);
        LAS float* egc = (LAS float*)(lds + S_EXP); LAS float* edec = egc + 64;
        if (tid < 64) { const float g = gcs[tid], gl = gcs[63]; egc[tid] = fexp(g); edec[tid] = fexp(gl - g); }
        f32x16 vn = zero16();
        f32x16 oa = zero16();
        {
            LAS const unsigned char* Ab = lds + S_WS + (32 * mt + l32) * 272 + 16 * h;
            LAS const unsigned char* Aq = lds + S_QS + (32 * mt + l32) * 272 + 16 * h;
            LAS const unsigned char* Bb = lds + S_ST + (32 * nt + l32) * STS + 16 * h;
#pragma unroll
            for (int ks = 0; ks < 8; ++ks) { const bf16x8 bfr = lds_b128(Bb + 32 * ks); vn = mfma32(lds_b128(Ab + 32 * ks), bfr, vn); oa = mfma32(lds_b128(Aq + 32 * ks), bfr, oa); }
            LAS const unsigned char* up = lds + S_US + (32 * mt + 4 * h) * 272 + (32 * nt + l32) * 2;
#pragma unroll
            for (int r = 0; r < 16; ++r) { const int ro = 8 * (r >> 2) + (r & 3); vn[r] = bf2f(*(LAS const bf16_t*)(up + ro * 272)) - vn[r]; }
        }
        __syncthreads();
        {
            const int ib = 32 * mt + 4 * h;
            LAS const float* edi = edec + ib;
            LAS unsigned char* w1p = lds + S_US + (32 * nt + l32) * VTS + ib * 2; LAS unsigned char* w2p = lds + S_WS + (32 * nt + l32) * VTS + ib * 2;
#pragma unroll
            for (int ig = 0; ig < 4; ++ig) {
                const float e0 = edi[8 * ig], e1 = edi[8 * ig + 1], e2 = edi[8 * ig + 2], e3 = edi[8 * ig + 3];
                u32x2 w = {pk2(vn[4 * ig], vn[4 * ig + 1]), pk2(vn[4 * ig + 2], vn[4 * ig + 3])};
                u32x2 ws = {pk2(vn[4 * ig] * e0, vn[4 * ig + 1] * e1), pk2(vn[4 * ig + 2] * e2, vn[4 * ig + 3] * e3)};
                *(LAS u32x2*)(w1p + 16 * ig) = w; *(LAS u32x2*)(w2p + 16 * ig) = ws;
            }
        }
        __syncthreads();
        {
            { LAS const float* egi = egc + 32 * mt + 4 * h;
#pragma unroll
              for (int r = 0; r < 16; ++r) oa[r] *= egi[8 * (r >> 2) + (r & 3)]; }
            LAS const unsigned char* A2 = lds + S_AT + (32 * mt + l32) * ATS + 16 * h;
            LAS const unsigned char* B2 = lds + S_US + (32 * nt + l32) * VTS + 16 * h;
#pragma unroll
            for (int ks = 0; ks < 4; ++ks) oa = mfma32(lds_b128(A2 + 32 * ks), lds_b128(B2 + 32 * ks), oa);
            const float eg = egc[63];
            st[0] = st[0] * eg; st[1] = st[1] * eg;
            LAS const unsigned char* kp = lds + S_KS + (8 * h + ((lane & 15) >> 2)) * 272 + (32 * mtk + 16 * ((lane >> 4) & 1) + 4 * (lane & 3)) * 2;
#pragma unroll
            for (int s = 0; s < 4; ++s) {
                const bf16x8 af = cat8(tr_read(kp + (16 * s) * 272), tr_read(kp + (16 * s + 4) * 272));
#pragma unroll
                for (int q = 0; q < 2; ++q) {
                    const bf16x8 bfr = lds_b128(lds + S_WS + (32 * (ntv0 + q) + l32) * VTS + (16 * s + 8 * h) * 2);
                    st[q] = mfma32(af, bfr, st[q]);
                }
            }
        }
        __syncthreads();
        {
            { LAS unsigned char* osw = lds + S_OS + (32 * mt + 4 * h) * 272 + (32 * nt + l32) * 2;
#pragma unroll
              for (int r = 0; r < 16; ++r) *(LAS bf16_t*)(osw + (8 * (r >> 2) + (r & 3)) * 272) = f2bf(oa[r]); }
#pragma unroll
            for (int q = 0; q < 2; ++q) { LAS unsigned char* sp = lds + S_ST + (32 * (ntv0 + q) + l32) * STS + (32 * mtk + 4 * h) * 2;
#pragma unroll
                for (int ig = 0; ig < 4; ++ig) {
                    u32x2 w = {pk2(st[q][4 * ig], st[q][4 * ig + 1]), pk2(st[q][4 * ig + 2], st[q][4 * ig + 3])};
                    *(LAS u32x2*)(sp + 16 * ig) = w; } }
            if (n < 31) dn_fill(nx, lds, tid);
        }
        __syncthreads();
        {
            const int r = tid >> 3, cc = tid & 7; const size_t grow = (size_t)b * SEQ + 64 * n + r;
            const u32x4 oa4 = *(LAS const u32x4*)(lds + S_OS + r * 272 + cc * 32), ob4 = *(LAS const u32x4*)(lds + S_OS + r * 272 + cc * 32 + 16);
            float y[16] = {bflo(oa4[0]), bfhi(oa4[0]), bflo(oa4[1]), bfhi(oa4[1]), bflo(oa4[2]), bfhi(oa4[2]), bflo(oa4[3]), bfhi(oa4[3]),
                           bflo(ob4[0]), bfhi(ob4[0]), bflo(ob4[1]), bfhi(ob4[1]), bflo(ob4[2]), bfhi(ob4[2]), bflo(ob4[3]), bfhi(ob4[3])};
            float ss = 0.f;
#pragma unroll
            for (int i = 0; i < 16; ++i) ss += y[i] * y[i];
            ss = sum8(ss);
            const float rs = rsqrtf(ss * (1.0f / 128.0f) + EPS);
            const float z[16] = {bflo(zc0[0]), bfhi(zc0[0]), bflo(zc0[1]), bfhi(zc0[1]), bflo(zc0[2]), bfhi(zc0[2]), bflo(zc0[3]), bfhi(zc0[3]),
                                 bflo(zc1[0]), bfhi(zc1[0]), bflo(zc1[1]), bfhi(zc1[1]), bflo(zc1[2]), bfhi(zc1[2]), bflo(zc1[3]), bfhi(zc1[3])};
#pragma unroll
            for (int i = 0; i < 16; ++i) y[i] = y[i] * rs * nwr[i >> 2][i & 3] * siluf_(z[i]);
            u32x4 wa = {pk2(y[0], y[1]), pk2(y[2], y[3]), pk2(y[4], y[5]), pk2(y[6], y[7])}, wb = {pk2(y[8], y[9]), pk2(y[10], y[11]), pk2(y[12], y[13]), pk2(y[14], y[15])};
            bf16_t* op = p.odn + grow * 1024 + hh * 128 + 16 * cc;
            *(u32x4*)op = wa; *(u32x4*)(op + 8) = wb;
            zc0 = nx.z0; zc1 = nx.z1;
        }
    }
    __syncthreads();
}

__device__ void phase_mixers(const Params& p, LAS unsigned char* lds) {
    LAS int* slot = (LAS int*)(lds + L_Q);
    for (;;) {
        __syncthreads();
        if (threadIdx.x == 0) *slot = (int)atomicAdd(p.ctr, 1u);
        __syncthreads();
        const int item = *slot;
        if (item >= 64 + 512 + 264) break;
        if (item < 64) dn_scan(p, item >> 3, item & 7, lds);
        else if (item < 576) { const int e = item - 64; const int qb = 31 - (e >> 4); nsa_item(p, (e >> 1) & 7, e & 1, qb, lds); }
        else {
            const int f = item - 576;
            if (f < 176) transpose_tiles<2, 256>(p.w_ffn_gate, p.w_ffn_up, DM, DFF, p.Wt_gu, NGU_P, (LAS float*)lds, f * 8, 1, f * 8 + 8, p.norm2_w);
            else transpose_tiles<0, 256>(p.w_ffn_down, nullptr, DFF, DM, p.Wt_dn, DM, (LAS float*)lds, (f - 176) * 8, 1, (f - 176) * 8 + 8);
        }
    }
}


#define XB_TMO      128
#define XB_XCNT(j)  (256  + 64 * (j))
#define XB_XSUB(j)  (1280 + 64 * (j))
#define XB_XGEN(j)  (2304 + 64 * (j))
#define XB_TOP      3328
#define XB_TOPGEN   3392
#define XCD_BAR_WORDS 3456
#define XB_SPIN_CAP (1u << 18)
DI unsigned xb_ld(unsigned* p)              { return __hip_atomic_load(p, __ATOMIC_RELAXED, __HIP_MEMORY_SCOPE_AGENT); }
DI unsigned xb_add(unsigned* p, unsigned v) { return __hip_atomic_fetch_add(p, v, __ATOMIC_RELAXED, __HIP_MEMORY_SCOPE_AGENT); }
DI unsigned xb_xcc_id() { return (unsigned)__builtin_amdgcn_s_getreg((3 << 11) | 20) & 0xFu; }
#define XB_SPIN(cond, bar) do { unsigned _sp = 0; while (cond) { __builtin_amdgcn_s_sleep(1); \
    if ((++_sp & 255u) == 0u) { if (xb_ld(&(bar)[XB_TMO])) break; if (_sp > XB_SPIN_CAP) { atomicAdd(&(bar)[XB_TMO], 1u); break; } } } } while (0)
struct XcdBarrier { unsigned* bar; unsigned x; volatile LAS unsigned* st; };
DI XcdBarrier xcd_barrier_post(unsigned* bar, volatile LAS unsigned* st) {
    XcdBarrier b; b.bar = bar; b.x = xb_xcc_id(); b.st = st;
    if (threadIdx.x == 0) (void)xb_add(&bar[XB_XCNT(b.x)], 1u);
    return b;
}
DI void xcd_barrier_complete(unsigned* bar, unsigned x, unsigned& nloc, unsigned& nx) {
    const unsigned G = gridDim.x * gridDim.y * gridDim.z;
    unsigned sum, cnt, mine, sp = 0u;
    for (;;) {
        sum = 0u; cnt = 0u; mine = 0u;
#pragma unroll
        for (unsigned j = 0; j < 16; ++j) { const unsigned c = xb_ld(&bar[XB_XCNT(j)]); sum += c; cnt += (c > 0u) ? 1u : 0u; mine = (j == x) ? c : mine; }
        if (sum == G) break;
        __builtin_amdgcn_s_sleep(1);
        if ((++sp & 255u) == 0u) { if (xb_ld(&bar[XB_TMO])) break; if (sp > XB_SPIN_CAP) { atomicAdd(&bar[XB_TMO], 1u); break; } }
    }
    nloc = mine > 0u ? mine : 1u; nx = cnt > 0u ? cnt : 1u;
}
DI void xcd_barrier_leader(unsigned* bar, unsigned x, volatile LAS unsigned* st) {
    __builtin_amdgcn_s_waitcnt(0);
    unsigned nloc = st[0], nx = st[1];
    if (nloc == 0u) { xcd_barrier_complete(bar, x, nloc, nx); st[0] = nloc; st[1] = nx; }
    const unsigned old = xb_add(&bar[XB_XSUB(x)], 1u);
    const unsigned gen = old / nloc;
    if (old + 1u == (gen + 1u) * nloc) {
        __builtin_amdgcn_fence(__ATOMIC_RELEASE, "agent");
        asm volatile("s_waitcnt vmcnt(0)" ::: "memory");
        const unsigned og = xb_add(&bar[XB_TOP], 1u);
        const unsigned tg = og / nx;
        if (og + 1u == (tg + 1u) * nx) xb_add(&bar[XB_TOPGEN], 1u);
        else XB_SPIN(xb_ld(&bar[XB_TOPGEN]) == tg, bar);
        __builtin_amdgcn_fence(__ATOMIC_ACQUIRE, "agent");
        xb_add(&bar[XB_XGEN(x)], 1u);
        asm volatile("s_waitcnt vmcnt(0)" ::: "memory");
    } else {
        XB_SPIN(xb_ld(&bar[XB_XGEN(x)]) == gen, bar);
        __builtin_amdgcn_fence(__ATOMIC_ACQUIRE, "agent");
        asm volatile("s_waitcnt vmcnt(0)" ::: "memory");
    }
}
DI void xcd_barrier(const XcdBarrier& b) {
    asm volatile("s_waitcnt vmcnt(0)" ::: "memory");
    __syncthreads();
    if (threadIdx.x == 0) xcd_barrier_leader(b.bar, b.x, b.st);
    __syncthreads();
}

__global__ __launch_bounds__(512, 2) void hybrid_block_megakernel(Params p) {
    extern __shared__ __attribute__((aligned(16))) unsigned char shm[];
    LAS unsigned char* lds = (LAS unsigned char*)shm;
    cg::grid_group grid = cg::this_grid();
    const int G = gridDim.x, c = blockIdx.x;
    __shared__ uint4 xb_words;
    if (threadIdx.x == 0) xb_words = make_uint4(0u, 0u, 0u, 0u);
    if (blockIdx.x == 0) { for (int i = threadIdx.x; i < XCD_BAR_WORDS; i += 512) p.bar[i] = 0u; }
    phase_prep(p, lds);
    grid.sync();
    const XcdBarrier xbar = xcd_barrier_post(p.bar, (volatile LAS unsigned*)&xb_words);
    { pg8::Gemm g{p.h, p.Wt_in, T_TOK, NIN_P, DM}; pg8::StaticOrder S; S.init(g.M, g.N, G, c);
      EpiInProj E{p.qbuf, p.kvbuf, p.dnqkv, p.dnz, p.mg, p.small, p.rcos, p.rsin}; pg8::gemm_phase(lds, g, S, E); }
    xcd_barrier(xbar);
    phase_compress(p, lds);
    { LAS int* slot = (LAS int*)(lds + L_Q);
      __syncthreads();
      if (threadIdx.x == 0) *slot = (int)atomicAdd(p.ctr + 1, 1u);
      __syncthreads();
      int item = *slot;
      PrepRegs R;
      if (item < 2048) dn_prep_issue(p, item, R, otid());
      while (item < 2048) item = dn_prep_item(p, item, R, lds);
    }
    xcd_barrier(xbar);
    phase_mixers(p, lds);
    xcd_barrier(xbar);
    { pg8::Gemm g{p.onsa, p.Wt_upn, T_TOK, DM, 1024}; pg8::StaticOrder S; S.init(g.M, g.N, G, c); EpiUp<0> E{p.mixed, p.mg, 0}; pg8::gemm_phase(lds, g, S, E); }
    { pg8::Gemm g{p.odn, p.Wt_upd, T_TOK, DM, 1024}; pg8::StaticOrder S; S.init(g.M, g.N, G, c); EpiUp<1> E{p.mixed, p.mg, 2048}; pg8::gemm_phase(lds, g, S, E); }
    xcd_barrier(xbar);
    { pg8::Gemm g{p.mixed, p.Wt_o, T_TOK, DM, DM}; pg8::StaticOrder S; S.init(g.M, g.N, G, c); EpiWo E{p.out, p.x, p.h, p.rowss}; pg8::gemm_phase(lds, g, S, E); }
    xcd_barrier(xbar);
    { pg8::Gemm g{p.h, p.Wt_gu, T_TOK, NGU_P, DM}; pg8::StaticOrder S; S.init(g.M, g.N, G, c); EpiGU E{p.act, p.rowss}; pg8::gemm_phase(lds, g, S, E); }
    xcd_barrier(xbar);
    { pg8::Gemm g{p.act, p.Wt_dn, T_TOK, DM, DFF}; pg8::StaticOrder S; S.init(g.M, g.N, G, c); EpiResF32<1> E{p.out, nullptr}; pg8::gemm_phase(lds, g, S, E); }
    xcd_barrier(xbar);
    rmsnorm_rows(p.out, p.norm_f_w, nullptr, p.out, T_TOK);
}

extern "C" void kernel_launch(void* const* d_in, const int* in_sizes, int n_in, void* d_out, int out_size, void* d_ws, size_t ws_size, hipStream_t stream) {
    constexpr size_t kDynLds = 131072;
    static int grid_blocks = 0;
    if (!grid_blocks) {
        int dev = 0, cus = 0, per_cu = 0;
        hipGetDevice(&dev);
        hipDeviceGetAttribute(&cus, hipDeviceAttributeMultiprocessorCount, dev);
        hipFuncSetAttribute((const void*)hybrid_block_megakernel, hipFuncAttributeMaxDynamicSharedMemorySize, (int)kDynLds);
        hipOccupancyMaxActiveBlocksPerMultiprocessor(&per_cu, hybrid_block_megakernel, 512, kDynLds);
        if (per_cu < 1) per_cu = 1;
        grid_blocks = cus * 1;
        if (grid_blocks > cus * per_cu) grid_blocks = cus * per_cu;
    }
    Params p{};
    const float* const* in = (const float* const*)d_in;
    p.x = in[0]; p.norm1_w = in[1]; p.w_in = in[2]; p.conv_w = in[3]; p.a_log = in[4]; p.dt_bias = in[5]; p.dn_norm_w = in[6];
    p.cmp_pe_k = in[7]; p.cmp_w1_k = in[8]; p.cmp_w2_k = in[9]; p.cmp_pe_v = in[10]; p.cmp_w1_v = in[11]; p.cmp_w2_v = in[12];
    p.w_up_nsa = in[13]; p.w_up_dn = in[14]; p.w_o = in[15]; p.norm2_w = in[16]; p.w_ffn_gate = in[17]; p.w_ffn_up = in[18]; p.w_ffn_down = in[19]; p.norm_f_w = in[20];
    p.out = (float*)d_out;
    unsigned char* w = (unsigned char*)d_ws; size_t off = 0;
    auto take = [&](size_t bytes) { unsigned char* r = w + off; off += (bytes + 255) & ~(size_t)255; return r; };
    p.ctr = (unsigned*)take(256); p.bar = (unsigned*)take(XCD_BAR_WORDS * 4);
    p.dn_q = (bf16_t*)take((size_t)T_TOK * 1024 * 2); p.dn_k = (bf16_t*)take((size_t)T_TOK * 1024 * 2);
    p.Wt_o = (bf16_t*)take((size_t)DM * DM * 2); p.Wt_upn = (bf16_t*)take((size_t)DM * 1024 * 2); p.Wt_upd = (bf16_t*)take((size_t)DM * 1024 * 2);
    p.W1t_k = (bf16_t*)take((size_t)128 * 4096 * 2); p.W1t_v = (bf16_t*)take((size_t)128 * 4096 * 2); p.W2t_k = (bf16_t*)take(128 * 128 * 2); p.W2t_v = (bf16_t*)take(128 * 128 * 2);
    p.rcos = (float*)take((size_t)SEQ * 64 * 4); p.rsin = (float*)take((size_t)SEQ * 64 * 4);
    p.kc = (bf16_t*)take((size_t)16 * 128 * 128 * 2); p.vc = (bf16_t*)take((size_t)16 * 128 * 128 * 2);
    p.small = (float*)take((size_t)T_TOK * 64 * 4); p.rowss = (float*)take((size_t)T_TOK * 4);
    p.h = (bf16_t*)take((size_t)T_TOK * DM * 2);
    p.onsa = p.h; p.odn = p.h + (size_t)T_TOK * 1024;
    p.qbuf = (bf16_t*)take((size_t)T_TOK * 1024 * 2); p.kvbuf = (bf16_t*)take((size_t)T_TOK * 1536 * 2);
    p.mixed = p.qbuf;
    p.dnqkv = (bf16_t*)take((size_t)T_TOK * 3072 * 2); p.dnz = (bf16_t*)take((size_t)T_TOK * 1024 * 2); p.onsa_f32 = (float*)take((size_t)T_TOK * 1024 * 4);
    p.Wt_gu = p.dnqkv; p.Wt_dn = p.Wt_gu + (size_t)NGU_P * DM;
    p.mg = (bf16_t*)d_out;
    p.Wt_in = (bf16_t*)take((size_t)NIN_P * DM * 2 + 39321600);
    p.act = p.dnz;
    p.dn_u = p.Wt_in; p.dn_w = p.dn_u + (size_t)T_TOK * 1024; p.dn_at = p.dn_w + (size_t)T_TOK * 1024; p.dn_gc = (float*)(p.dn_at + (size_t)2048 * 4096);
    if (off > ws_size) { fprintf(stderr, "workspace too small: need %zu have %zu\n", off, ws_size); return; }
    void* args[] = {&p};
    hipError_t e = hipLaunchCooperativeKernel((void*)hybrid_block_megakernel, dim3(grid_blocks), dim3(512), args, kDynLds, stream);
    if (e != hipSuccess) fprintf(stderr, "cooperative launch failed: %s (grid %d)\n", hipGetErrorString(e), grid_blocks);
}
```
